# Optimizing an MI355X kernel written in HIP

```python
import numpy as np
import jax, jax.numpy as jnp
from jax import lax

D_MODEL = 1024
BATCH = 8
SEQ = 4096
DEPTH = 1

HEAD_DIM = 64
ROT_DIM = HEAD_DIM // 4
ROPE_THETA = 500000.0
NORM_EPS = 1e-6

NSA_HEADS = 8
NSA_KV_GROUPS = 2
NSA_GROUP_SIZE = NSA_HEADS // NSA_KV_GROUPS
CMP_BLOCK = 32
CMP_STRIDE = 16
SEL_BLOCK = 64
SEL_TOPN = 16
WINDOW = 512
NSA_Q_CHUNK = 32

MOBA_HEADS = 8
MOBA_BLOCK = 256
MOBA_TOPK = 3
MOBA_Q_CHUNK = 16

D_FF = 4 * D_MODEL

NSA_WIDTH = NSA_HEADS * HEAD_DIM
KV_WIDTH = NSA_KV_GROUPS * HEAD_DIM
MOBA_WIDTH = MOBA_HEADS * HEAD_DIM
OFF_KV = NSA_WIDTH
OFF_GN = OFF_KV + 6 * KV_WIDTH
OFF_M = OFF_GN + 3 * NSA_HEADS
OFF_GM = OFF_M + 3 * MOBA_WIDTH
IN_WIDTH = OFF_GM + 2 * D_MODEL

kernel_name = "hybrid_nsa_moba_gated_block"


def rmsnorm(x, g):
    xf = x.astype(jnp.float32)
    y = xf * lax.rsqrt(jnp.mean(xf * xf, axis=-1, keepdims=True) + NORM_EPS)
    return (y * g.astype(jnp.float32)).astype(x.dtype)


def rope_tables(seq):
    inv = ROPE_THETA ** (-jnp.arange(0, ROT_DIM, 2, dtype=jnp.float32) / ROT_DIM)
    ang = jnp.arange(seq, dtype=jnp.float32)[:, None] * inv[None, :]
    return jnp.cos(ang), jnp.sin(ang)


def partial_rope(x, cos, sin):
    half = ROT_DIM // 2
    x1 = x[..., :half].astype(jnp.float32)
    x2 = x[..., half:ROT_DIM].astype(jnp.float32)
    c = cos[:, None, :]
    s = sin[:, None, :]
    rot = jnp.concatenate([x1 * c - x2 * s, x1 * s + x2 * c], axis=-1).astype(x.dtype)
    return jnp.concatenate([rot, x[..., ROT_DIM:]], axis=-1)


def masked_softmax(s, mask):
    s = jnp.where(mask, s.astype(jnp.float32), -jnp.inf)
    m = jnp.max(s, axis=-1, keepdims=True)
    m = jnp.where(jnp.isfinite(m), m, 0.0)
    p = jnp.where(mask, jnp.exp(s - m), 0.0)
    return p / jnp.maximum(jnp.sum(p, axis=-1, keepdims=True), 1e-30)


def compress_blocks(k, pe, w1, w2):
    b, seq, g, d = k.shape
    n_cmp = (seq - CMP_BLOCK) // CMP_STRIDE + 1
    idx = jnp.arange(n_cmp)[:, None] * CMP_STRIDE + jnp.arange(CMP_BLOCK)[None, :]
    kb = k[:, idx] + pe[None, None, :, None, :]
    kb = jnp.transpose(kb, (0, 3, 1, 2, 4)).reshape(b, g, n_cmp, CMP_BLOCK * d)
    return jax.nn.gelu(kb @ w1) @ w2


def cmp_to_sel_overlap(n_cmp, n_blk):
    i = np.arange(n_cmp)[:, None]
    j = np.arange(n_blk)[None, :]
    start = i * CMP_STRIDE
    end = start + CMP_BLOCK - 1
    return ((end >= j * SEL_BLOCK) & (start <= j * SEL_BLOCK + SEL_BLOCK - 1)).astype(np.float32)


def nsa_attention(q, q_rot, kc, vc, ks, vs, kw, vw, gates):
    b, g, r, seq, d = q.shape
    n_cmp = kc.shape[2]
    n_blk = seq // SEL_BLOCK
    n_top = min(SEL_TOPN, n_blk)
    scale = d ** -0.5
    qc_n = NSA_Q_CHUNK
    overlap = jnp.asarray(cmp_to_sel_overlap(n_cmp, n_blk))
    ks_blk = ks.reshape(b, g, n_blk, SEL_BLOCK, d)
    vs_blk = vs.reshape(b, g, n_blk, SEL_BLOCK, d)
    kw_pad = jnp.pad(kw, ((0, 0), (0, 0), (WINDOW, 0), (0, 0)))
    vw_pad = jnp.pad(vw, ((0, 0), (0, 0), (WINDOW, 0), (0, 0)))
    cmp_end = jnp.arange(n_cmp) * CMP_STRIDE + CMP_BLOCK - 1
    blk_ids = jnp.arange(n_blk)
    bi = jnp.arange(b)[:, None, None, None]
    gi = jnp.arange(g)[None, :, None, None]

    def chunk(c):
        t0 = c * qc_n
        t = t0 + jnp.arange(qc_n)
        qq = lax.dynamic_slice_in_dim(q, t0, qc_n, axis=3)
        qr = lax.dynamic_slice_in_dim(q_rot, t0, qc_n, axis=3)
        gc = lax.dynamic_slice_in_dim(gates, t0, qc_n, axis=3)
        s_cmp = jnp.einsum('bgrqd,bgnd->bgrqn', qq, kc) * scale
        p_cmp = masked_softmax(s_cmp, cmp_end[None, :] <= t[:, None])
        o_cmp = jnp.einsum('bgrqn,bgnd->bgrqd', p_cmp.astype(vc.dtype), vc)
        imp = jnp.einsum('bgrqn,nj->bgqj', p_cmp, overlap)
        cur = t // SEL_BLOCK
        jj = blk_ids[None, :]
        forced = (jj == 0) | (jj == cur[:, None]) | (jj == cur[:, None] - 1)
        imp = jnp.where(forced, jnp.inf, imp)
        imp = jnp.where(jj <= cur[:, None], imp, -jnp.inf)
        _, top_i = lax.top_k(imp, n_top)
        ksel = ks_blk[bi, gi, top_i]
        vsel = vs_blk[bi, gi, top_i]
        s_sel = jnp.einsum('bgrqd,bgqnld->bgrqnl', qr, ksel) * scale
        kpos = top_i[..., None] * SEL_BLOCK + jnp.arange(SEL_BLOCK)
        m_sel = kpos <= t[:, None, None]
        p_sel = masked_softmax(s_sel.reshape(b, g, r, qc_n, -1),
                               m_sel[:, :, None].reshape(b, g, 1, qc_n, -1))
        o_sel = jnp.einsum('bgrqm,bgqmd->bgrqd', p_sel.astype(vs.dtype),
                           vsel.reshape(b, g, qc_n, -1, d))
        kwin = lax.dynamic_slice_in_dim(kw_pad, t0, WINDOW + qc_n, axis=2)
        vwin = lax.dynamic_slice_in_dim(vw_pad, t0, WINDOW + qc_n, axis=2)
        wpos = t0 - WINDOW + jnp.arange(WINDOW + qc_n)
        m_win = ((wpos[None, :] <= t[:, None]) & (wpos[None, :] > t[:, None] - WINDOW)
                 & (wpos[None, :] >= 0))
        s_win = jnp.einsum('bgrqd,bgkd->bgrqk', qr, kwin) * scale
        p_win = masked_softmax(s_win, m_win)
        o_win = jnp.einsum('bgrqk,bgkd->bgrqd', p_win.astype(vw.dtype), vwin)
        return gc[..., 0:1] * o_cmp + gc[..., 1:2] * o_sel + gc[..., 2:3] * o_win

    out = lax.map(chunk, jnp.arange(seq // qc_n))
    return jnp.transpose(out, (1, 0, 4, 2, 3, 5)).reshape(b, seq, g * r * d)


def moba_attention(q, k, v):
    b, h, seq, d = q.shape
    n_blk = -(-seq // MOBA_BLOCK)
    pad = n_blk * MOBA_BLOCK - seq
    scale = d ** -0.5
    qc_n = MOBA_Q_CHUNK
    kp = jnp.pad(k, ((0, 0), (0, 0), (0, pad), (0, 0)))
    vp = jnp.pad(v, ((0, 0), (0, 0), (0, pad), (0, 0)))
    k_blk = kp.reshape(b, h, n_blk, MOBA_BLOCK, d)
    v_blk = vp.reshape(b, h, n_blk, MOBA_BLOCK, d)
    k_mean = jnp.mean(k_blk.astype(jnp.float32), axis=3).astype(k.dtype)
    n_top = min(MOBA_TOPK, n_blk)
    blk_ids = jnp.arange(n_blk)
    bi = jnp.arange(b)[:, None, None, None]
    hi = jnp.arange(h)[None, :, None, None]

    def chunk(c):
        t0 = c * qc_n
        t = t0 + jnp.arange(qc_n)
        qq = lax.dynamic_slice_in_dim(q, t0, qc_n, axis=2)
        own = t0 // MOBA_BLOCK
        gate = jnp.einsum('bhqd,bhnd->bhqn', qq, k_mean).astype(jnp.float32)
        gate = jnp.where(blk_ids < own, gate, -jnp.inf)
        top_s, top_i = lax.top_k(gate, n_top)
        valid = top_s > -jnp.inf
        kg = k_blk[bi, hi, top_i]
        vg = v_blk[bi, hi, top_i]
        s_past = jnp.einsum('bhqd,bhqkld->bhqkl', qq, kg).reshape(b, h, qc_n, -1) * scale
        m_past = jnp.broadcast_to(valid[..., None], (b, h, qc_n, n_top, MOBA_BLOCK)).reshape(b, h, qc_n, -1)
        k_own = lax.dynamic_slice_in_dim(kp, own * MOBA_BLOCK, MOBA_BLOCK, axis=2)
        v_own = lax.dynamic_slice_in_dim(vp, own * MOBA_BLOCK, MOBA_BLOCK, axis=2)
        s_own = jnp.einsum('bhqd,bhld->bhql', qq, k_own) * scale
        m_own = (own * MOBA_BLOCK + jnp.arange(MOBA_BLOCK))[None, :] <= t[:, None]
        s = jnp.concatenate([s_past, s_own], axis=-1)
        m = jnp.concatenate([m_past, jnp.broadcast_to(m_own, (b, h, qc_n, MOBA_BLOCK))], axis=-1)
        p = masked_softmax(s, m).astype(v.dtype)
        n_past = n_top * MOBA_BLOCK
        return (jnp.einsum('bhqm,bhqmd->bhqd', p[..., :n_past], vg.reshape(b, h, qc_n, -1, d))
                + jnp.einsum('bhql,bhld->bhqd', p[..., n_past:], v_own))

    out = lax.map(chunk, jnp.arange(seq // qc_n))
    return jnp.transpose(out, (1, 0, 3, 2, 4)).reshape(b, seq, h * d)


def setup_inputs(seed: int = 0) -> dict:
    key = jax.random.key(seed)
    ks = jax.random.split(key, 17)
    f32 = jnp.float32

    def nrm(k, shape, fan_in):
        return jax.random.normal(k, shape, f32) * (fan_in ** -0.5)

    def gain(k, shape):
        return 1.0 + 0.01 * jax.random.normal(k, shape, f32)

    L = DEPTH
    return {
        "x": jax.random.normal(ks[0], (BATCH, SEQ, D_MODEL), f32),
        "norm1_g": gain(ks[1], (L, D_MODEL)),
        "w_in": nrm(ks[2], (L, D_MODEL, IN_WIDTH), D_MODEL),
        "cmp_pe_k": 0.02 * jax.random.normal(ks[3], (L, CMP_BLOCK, HEAD_DIM), f32),
        "cmp_pe_v": 0.02 * jax.random.normal(ks[4], (L, CMP_BLOCK, HEAD_DIM), f32),
        "cmp_k_w1": nrm(ks[5], (L, CMP_BLOCK * HEAD_DIM, HEAD_DIM), CMP_BLOCK * HEAD_DIM),
        "cmp_k_w2": nrm(ks[6], (L, HEAD_DIM, HEAD_DIM), HEAD_DIM),
        "cmp_v_w1": nrm(ks[7], (L, CMP_BLOCK * HEAD_DIM, HEAD_DIM), CMP_BLOCK * HEAD_DIM),
        "cmp_v_w2": nrm(ks[8], (L, HEAD_DIM, HEAD_DIM), HEAD_DIM),
        "w_up_nsa": nrm(ks[9], (L, NSA_WIDTH, D_MODEL), NSA_WIDTH),
        "w_up_moba": nrm(ks[10], (L, MOBA_WIDTH, D_MODEL), MOBA_WIDTH),
        "w_out": nrm(ks[11], (L, D_MODEL, D_MODEL), D_MODEL),
        "norm2_g": gain(ks[12], (L, D_MODEL)),
        "w_ff1": nrm(ks[13], (L, D_MODEL, D_FF), D_MODEL),
        "w_ff2": nrm(ks[14], (L, D_FF, D_MODEL), D_FF),
        "norm_f_g": gain(ks[15], (D_MODEL,)),
    }


def reference(x, norm1_g, w_in, cmp_pe_k, cmp_pe_v, cmp_k_w1, cmp_k_w2, cmp_v_w1, cmp_v_w2,
              w_up_nsa, w_up_moba, w_out, norm2_g, w_ff1, w_ff2, norm_f_g):
    b, seq, _ = x.shape
    cos, sin = rope_tables(seq)
    G, R, d = NSA_KV_GROUPS, NSA_GROUP_SIZE, HEAD_DIM
    for layer in range(DEPTH):
        h = rmsnorm(x, norm1_g[layer])
        proj = h @ w_in[layer]
        q_n = proj[..., :OFF_KV]
        kv_n = proj[..., OFF_KV:OFF_GN]
        g_n = proj[..., OFF_GN:OFF_M]
        qkv_m = proj[..., OFF_M:OFF_GM]
        g_m = proj[..., OFF_GM:]

        q = q_n.reshape(b, seq, NSA_HEADS, d)
        q_r = partial_rope(q, cos, sin)
        kv = kv_n.reshape(b, seq, 6, G, d)
        k_c, v_c, k_s, v_s, k_w, v_w = (kv[:, :, i] for i in range(6))
        k_s = partial_rope(k_s, cos, sin)
        k_w = partial_rope(k_w, cos, sin)
        kc = compress_blocks(k_c, cmp_pe_k[layer], cmp_k_w1[layer], cmp_k_w2[layer])
        vc = compress_blocks(v_c, cmp_pe_v[layer], cmp_v_w1[layer], cmp_v_w2[layer])
        to_q = lambda t: jnp.transpose(t.reshape(b, seq, G, R, d), (0, 2, 3, 1, 4))
        to_kv = lambda t: jnp.transpose(t, (0, 2, 1, 3))
        gates = jnp.transpose(
            jax.nn.sigmoid(g_n.astype(jnp.float32)).reshape(b, seq, G, R, 3),
            (0, 2, 3, 1, 4)).astype(x.dtype)
        y_nsa = nsa_attention(to_q(q), to_q(q_r), kc, vc, to_kv(k_s), to_kv(v_s),
                              to_kv(k_w), to_kv(v_w), gates)

        qkv = qkv_m.reshape(b, seq, 3, MOBA_HEADS, d)
        qm = partial_rope(qkv[:, :, 0], cos, sin)
        km = partial_rope(qkv[:, :, 1], cos, sin)
        vm = qkv[:, :, 2]
        y_moba = moba_attention(to_kv(qm), to_kv(km), to_kv(vm))

        gm = jax.nn.sigmoid(g_m.astype(jnp.float32)).astype(x.dtype)
        g_nsa = gm[..., :D_MODEL]
        g_moba = gm[..., D_MODEL:]
        mixed = g_nsa * (y_nsa @ w_up_nsa[layer]) + g_moba * (y_moba @ w_up_moba[layer])
        x = x + mixed @ w_out[layer]

        h2 = rmsnorm(x, norm2_g[layer])
        u = jax.nn.relu(h2 @ w_ff1[layer])
        x = x + (u * u) @ w_ff2[layer]
    return rmsnorm(x, norm_f_g)
```

```cpp
#include <hip/hip_runtime.h>
#include <cstdio>
#include <cstdint>
#include <cmath>
namespace pg8 {
#define PG8_LAS __attribute__((address_space(3)))
typedef unsigned short bf16_t;
typedef short bf16x8 __attribute__((ext_vector_type(8)));
typedef float f32x4 __attribute__((ext_vector_type(4)));
typedef unsigned u32x4 __attribute__((ext_vector_type(4)));
constexpr int BM = 256, BK = 64, HALF = 128, HTB = HALF * BK * 2  , STAGE_BYTES = 8 * HTB, NXCD = 8, WGM = 8;

__host__ __device__ __forceinline__ int lds_byte(int r, int c) { const int st = (r >> 4) * 2 + (c >> 5), rr = r & 15, cc = c & 31, ob = rr * 64 + cc * 2; return st * 1024 + (ob ^ (((ob >> 9) & 1) << 5)); }
__host__ __device__ __forceinline__ void stage_rc(int b, int& R, int& C) { const int st = b / 1024, sb = b % 1024, swz = sb ^ (((sb >> 9) & 1) << 5); R = (st >> 1) * 16 + swz / 64; C = (st & 1) * 32 + (swz % 64) / 2; }
__host__ __device__ __forceinline__ int perm32(int rho) { const int n = rho >> 4, i = rho & 15; return 8 * (i >> 2) + 4 * n + (i & 3); }

struct Unit { int pm, pn, src; };
struct Gemm { const bf16_t* A; const bf16_t* Bt; const bf16_t* A2; const bf16_t* Bt2; int M, N, K; };
struct StaticOrder {
    int nM, nN, nwg, G, c;
    __host__ __device__ void init(int M, int N, int G_, int c_) { nM = M / BM; nN = N / BM; nwg = nM * nN; G = G_; c = c_; }
    __host__ __device__ bool tile(long L, Unit& u) const {
        if (L >= nwg) return false;
        int wgid = (int)L; { const int q = nwg / NXCD, r = nwg % NXCD, xcd = wgid % NXCD, off = wgid / NXCD; wgid = (xcd < r ? xcd * (q + 1) : r * (q + 1) + (xcd - r) * q) + off; }
        const int nig = WGM * nN, gid = wgid / nig, fm = gid * WGM, gsz = (nM - fm) < WGM ? (nM - fm) : WGM;
        u.pm = fm + ((wgid % nig) % gsz); u.pn = (wgid % nig) / gsz; return true;
    }
    __host__ __device__ bool next(int i, Unit& u) const { u.src = 0; return tile((long)i * G + c, u); }
    __device__ __forceinline__ void a_ready(const Unit&) const {}
    __device__ __forceinline__ void done(const Unit&) const {}
};
struct PairOrder : StaticOrder {
    __host__ __device__ bool next(int i, Unit& u) const { u.src = i & 1; return tile((long)(i >> 1) * G + c, u); }
};
__device__ __forceinline__ unsigned cvt_pk_bf16(float lo, float hi) { unsigned r; asm volatile("v_cvt_pk_bf16_f32 %0, %1, %2" : "=v"(r) : "v"(lo), "v"(hi)); return r; }
template <class Epi, class Sched, bool ALIGN_EPI = false, bool SP2 = false>
__device__ __forceinline__ void gemm_phase(PG8_LAS unsigned char* lds, const Gemm g, const Sched& S, const Epi& E) {
    const int tid = threadIdx.x, wid = __builtin_amdgcn_readfirstlane(tid >> 6), lane = tid & 63, wr = wid >> 2, wc = wid & 3, fr = lane & 15, fq = lane >> 4;
    const int K = g.K, nt = K / BK;
    unsigned voffA[2], voffB[2];
#pragma unroll
    for (int i = 0; i < 2; ++i) { int R, C; stage_rc(tid * 16 + i * 8192, R, C); const int Rb = Epi::PERM ? ((R & ~31) + perm32(R & 31)) : R;
        voffA[i] = (unsigned)(R * K + C) * 2u; voffB[i] = (unsigned)(Rb * K + C) * 2u; }
    const size_t kstep = (size_t)(BK * 2);
    const size_t hstep = (size_t)HALF * K * 2;
    const size_t tstep = 2 * hstep;
    const unsigned ldsw = (unsigned)wid * 1024u;
    const int aoff = lds_byte(wr * 64 + fr, fq * 8), boff = lds_byte(wc * 32 + fr, fq * 8);
#define PG8_SA(b, h) (((b) * 2 + (h)) * HTB)
#define PG8_SB(b, h) ((4 + (b) * 2 + (h)) * HTB)
#define PG8_STAGE(bufoff, gbase, voff) do { _Pragma("unroll") for (int _i = 0; _i < 2; ++_i) \
        __builtin_amdgcn_global_load_lds((const unsigned*)((const char*)(gbase) + (voff)[_i]), (PG8_LAS unsigned*)(lds + (bufoff) + ldsw + _i * 8192), 16, 0, 0); } while (0)
#define PG8_LDA(dst, b, h) do { _Pragma("unroll") for (int m = 0; m < 4; ++m) _Pragma("unroll") for (int k = 0; k < 2; ++k) dst[m][k] = *(const PG8_LAS bf16x8*)(lds + PG8_SA(b, h) + aoff + m * 2048 + k * 1024); } while (0)
#define PG8_LDB(dst, b, h) do { _Pragma("unroll") for (int n = 0; n < 2; ++n) _Pragma("unroll") for (int k = 0; k < 2; ++k) dst[n][k] = *(const PG8_LAS bf16x8*)(lds + PG8_SB(b, h) + boff + n * 2048 + k * 1024); } while (0)
#define PG8_MMA(ai, bj, At, Bt) do { __builtin_amdgcn_s_setprio(1); _Pragma("unroll") for (int m = 0; m < 4; ++m) _Pragma("unroll") for (int n = 0; n < 2; ++n) _Pragma("unroll") for (int k = 0; k < 2; ++k) \
        acc[ai][bj][m][n] = __builtin_amdgcn_mfma_f32_16x16x32_bf16(Bt[n][k], At[m][k], acc[ai][bj][m][n], 0, 0, 0); __builtin_amdgcn_s_setprio(0); } while (0)
#define PG8_WAIT_V(n) asm volatile("s_waitcnt vmcnt(" #n ")" ::: "memory")
#define PG8_WAIT_L(n) asm volatile("s_waitcnt lgkmcnt(" #n ")" ::: "memory")
#define PG8_BAR __builtin_amdgcn_s_barrier()
#define PG8_SCHED __builtin_amdgcn_sched_barrier(0)
    Unit cur, nxt; int ui = 0;
    if (!S.next(0, cur)) return;
    f32x4 acc[2][2][4][2];
#pragma unroll
    for (int a = 0; a < 2; ++a)
#pragma unroll
        for (int b = 0; b < 2; ++b)
#pragma unroll
            for (int m = 0; m < 4; ++m)
#pragma unroll
                for (int n = 0; n < 2; ++n) acc[a][b][m][n] = (f32x4){0.f, 0.f, 0.f, 0.f};
    bf16x8 At[4][2], B0[2][2], B1[2][2];
    const char* cA = (const char*)(cur.src ? g.A2 : g.A) + (size_t)cur.pm * tstep; const char* cB = (const char*)(cur.src ? g.Bt2 : g.Bt) + (size_t)cur.pn * tstep;
    S.a_ready(cur);
    if constexpr (SP2) {
        PG8_STAGE(PG8_SB(0, 0), cB, voffB); PG8_STAGE(PG8_SB(0, 1), cB + hstep, voffB); PG8_STAGE(PG8_SA(0, 0), cA, voffA); PG8_STAGE(PG8_SA(0, 1), cA + hstep, voffA);
        if (wr == 1) PG8_BAR;
        PG8_WAIT_V(2); PG8_BAR;
        PG8_STAGE(PG8_SB(1, 0), cB + kstep, voffB); PG8_STAGE(PG8_SA(1, 0), cA + kstep, voffA); PG8_STAGE(PG8_SB(1, 1), cB + hstep + kstep, voffB);
        PG8_WAIT_V(6); PG8_BAR;
    } else {
        PG8_STAGE(PG8_SB(0, 0), cB, voffB); PG8_STAGE(PG8_SA(0, 0), cA, voffA); PG8_STAGE(PG8_SB(0, 1), cB + hstep, voffB); PG8_STAGE(PG8_SA(0, 1), cA + hstep, voffA);
        if (wr == 1) PG8_BAR;
        PG8_WAIT_V(4); PG8_BAR;
        PG8_STAGE(PG8_SB(1, 0), cB + kstep, voffB); PG8_STAGE(PG8_SA(1, 0), cA + kstep, voffA); PG8_STAGE(PG8_SB(1, 1), cB + hstep + kstep, voffB);
        PG8_WAIT_V(6); PG8_BAR;
    }
    for (;;) {
        const bool has_next = S.next(ui + 1, nxt);
        const char* nA = has_next ? (const char*)(nxt.src ? g.A2 : g.A) + (size_t)nxt.pm * tstep : cA; const char* nB = has_next ? (const char*)(nxt.src ? g.Bt2 : g.Bt) + (size_t)nxt.pn * tstep : cB;
        for (int t = 0; t < nt; t += 2) {
            const bool last = (t == nt - 2);
            const char* a1 = cA + (size_t)(t + 1) * kstep;
            const char* a2 = last ? nA : cA + (size_t)(t + 2) * kstep; const char* b2 = last ? nB : cB + (size_t)(t + 2) * kstep;
            const char* a3 = a2 + kstep; const char* b3 = b2 + kstep;
            if (last && has_next) S.a_ready(nxt);
            if constexpr (SP2) {
            PG8_LDB(B0, 0, 0); PG8_LDB(B1, 0, 1); PG8_SCHED; PG8_LDA(At, 0, 0); PG8_STAGE(PG8_SA(1, 1), a1 + hstep, voffA);
            PG8_WAIT_V(8); PG8_WAIT_L(0); PG8_BAR; PG8_MMA(0, 0, At, B0); PG8_MMA(0, 1, At, B1); PG8_BAR; PG8_SCHED;
            PG8_LDA(At, 0, 1); PG8_STAGE(PG8_SB(0, 0), b2, voffB); PG8_STAGE(PG8_SB(0, 1), b2 + hstep, voffB); PG8_STAGE(PG8_SA(0, 0), a2, voffA);
            PG8_WAIT_V(8); PG8_WAIT_L(0); PG8_BAR; PG8_MMA(1, 0, At, B0); PG8_MMA(1, 1, At, B1); PG8_BAR; PG8_SCHED;
            PG8_LDB(B0, 1, 0); PG8_LDB(B1, 1, 1); PG8_SCHED; PG8_LDA(At, 1, 0); PG8_STAGE(PG8_SA(0, 1), a2 + hstep, voffA);
            PG8_WAIT_V(8); PG8_WAIT_L(0); PG8_BAR; PG8_MMA(0, 0, At, B0); PG8_MMA(0, 1, At, B1); PG8_BAR; PG8_SCHED;
            PG8_LDA(At, 1, 1); PG8_STAGE(PG8_SB(1, 0), b3, voffB); PG8_STAGE(PG8_SB(1, 1), b3 + hstep, voffB); PG8_STAGE(PG8_SA(1, 0), a3, voffA);
            PG8_WAIT_V(8); PG8_WAIT_L(0); PG8_BAR; PG8_MMA(1, 0, At, B0); PG8_MMA(1, 1, At, B1); PG8_BAR; PG8_SCHED;
            } else {
            PG8_LDB(B0, 0, 0); PG8_SCHED; PG8_LDA(At, 0, 0); PG8_STAGE(PG8_SA(1, 1), a1 + hstep, voffA);
            PG8_WAIT_L(8); PG8_BAR; PG8_WAIT_L(0); PG8_MMA(0, 0, At, B0); PG8_BAR; PG8_SCHED;
            PG8_LDB(B1, 0, 1); PG8_STAGE(PG8_SB(0, 0), b2, voffB);
            PG8_BAR; PG8_WAIT_L(0); PG8_MMA(0, 1, At, B1); PG8_BAR;
            PG8_LDA(At, 0, 1); PG8_STAGE(PG8_SA(0, 0), a2, voffA);
            PG8_BAR; PG8_WAIT_L(0); PG8_MMA(1, 0, At, B0); PG8_BAR; PG8_SCHED;
            PG8_STAGE(PG8_SB(0, 1), b2 + hstep, voffB);
            PG8_WAIT_V(6); PG8_BAR; PG8_MMA(1, 1, At, B1); PG8_BAR;
            PG8_LDB(B0, 1, 0); PG8_SCHED; PG8_LDA(At, 1, 0); PG8_STAGE(PG8_SA(0, 1), a2 + hstep, voffA);
            PG8_WAIT_L(8); PG8_BAR; PG8_WAIT_L(0); PG8_MMA(0, 0, At, B0); PG8_BAR; PG8_SCHED;
            PG8_LDB(B1, 1, 1); PG8_STAGE(PG8_SB(1, 0), b3, voffB);
            PG8_BAR; PG8_WAIT_L(0); PG8_MMA(0, 1, At, B1); PG8_BAR;
            PG8_LDA(At, 1, 1); PG8_STAGE(PG8_SA(1, 0), a3, voffA);
            PG8_BAR; PG8_WAIT_L(0); PG8_MMA(1, 0, At, B0); PG8_BAR; PG8_SCHED;
            PG8_STAGE(PG8_SB(1, 1), b3 + hstep, voffB);
            PG8_WAIT_V(6); PG8_BAR; PG8_MMA(1, 1, At, B1); PG8_BAR;
            }
        }
        if constexpr (ALIGN_EPI) { if (wr == 0) PG8_BAR; }
        if constexpr (!Epi::AFTER_DRAIN) { E(acc, cur, wr, wc, fr, fq); S.done(cur); }
        if (!has_next) break;
#pragma unroll
        for (int a = 0; a < 2; ++a)
#pragma unroll
            for (int b = 0; b < 2; ++b)
#pragma unroll
                for (int m = 0; m < 4; ++m)
#pragma unroll
                    for (int n = 0; n < 2; ++n) acc[a][b][m][n] = (f32x4){0.f, 0.f, 0.f, 0.f};
        cur = nxt; cA = nA; cB = nB; ++ui;
        if constexpr (ALIGN_EPI) { if (wr == 1) PG8_BAR; }
    }
    PG8_WAIT_V(0);
    if constexpr (!ALIGN_EPI) { if (wr == 0) PG8_BAR; }
    PG8_BAR;
    if constexpr (Epi::AFTER_DRAIN) { E.fused(acc, cur, wr, wc, fr, fq, lds, wid, lane); S.done(cur); }
#undef PG8_SA
#undef PG8_SB
#undef PG8_STAGE
#undef PG8_LDA
#undef PG8_LDB
#undef PG8_MMA
#undef PG8_WAIT_V
#undef PG8_WAIT_L
#undef PG8_BAR
#undef PG8_SCHED
}
}
#define GAS __attribute__((address_space(1)))
#define LAS __attribute__((address_space(3)))
typedef unsigned short bf16;
typedef unsigned v4u __attribute__((ext_vector_type(4)));
typedef float f32x4 __attribute__((ext_vector_type(4)));
typedef short bf16x8 __attribute__((ext_vector_type(8)));
typedef GAS unsigned gu32;
typedef GAS unsigned long long gu64;
#define RLX_AGENT __ATOMIC_RELAXED, __HIP_MEMORY_SCOPE_AGENT
#define LDS_WAIT() asm volatile("s_waitcnt lgkmcnt(0)" ::: "memory")
#define VM_WAIT() asm volatile("s_waitcnt vmcnt(0)" ::: "memory")
__device__ __forceinline__ unsigned long long rt() { return __builtin_amdgcn_s_memrealtime(); }
__device__ __forceinline__ unsigned f2bf(float f) { unsigned u = __builtin_bit_cast(unsigned, f); return (u + 0x7fffu + ((u >> 16) & 1u)) >> 16; }
__device__ __forceinline__ unsigned pk2(float lo, float hi) { return f2bf(lo) | (f2bf(hi) << 16); }

#define XB_TMO      128
#define XB_XCNT(j)  (256  + 64 * (j))
#define XB_XSUB(j)  (1280 + 64 * (j))
#define XB_XGEN(j)  (2304 + 64 * (j))
#define XB_TOP      3328
#define XB_TOPGEN   3392
#define XCD_BAR_WORDS 3456
#define XB_SPIN_CAP (1u << 18)

__device__ __forceinline__ unsigned xb_ld(unsigned* p)              { return __hip_atomic_load(p, __ATOMIC_RELAXED, __HIP_MEMORY_SCOPE_AGENT); }
__device__ __forceinline__ unsigned xb_add(unsigned* p, unsigned v) { return __hip_atomic_fetch_add(p, v, __ATOMIC_RELAXED, __HIP_MEMORY_SCOPE_AGENT); }
__device__ __forceinline__ unsigned xb_xcc_id() { return (unsigned)__builtin_amdgcn_s_getreg((3 << 11) | 20) & 0xFu; }
#define XB_SPIN(cond, bar) do { unsigned _sp = 0; while (cond) { __builtin_amdgcn_s_sleep(1); \
    if ((++_sp & 255u) == 0u) { if (xb_ld(&(bar)[XB_TMO])) break; if (_sp > XB_SPIN_CAP) { atomicAdd(&(bar)[XB_TMO], 1u); break; } } } } while (0)

struct XcdBarrier {
    unsigned* bar; unsigned x;
    volatile LAS unsigned* st;
};

__device__ __forceinline__ XcdBarrier xcd_barrier_post(unsigned* bar, volatile LAS unsigned* st) {
    XcdBarrier b; b.bar = bar; b.x = xb_xcc_id(); b.st = st;
    if (threadIdx.x == 0) (void)xb_add(&bar[XB_XCNT(b.x)], 1u);
    return b;
}
__device__ __forceinline__ void xcd_barrier_complete(unsigned* bar, unsigned x, unsigned& nloc, unsigned& nx) {
    const unsigned G = gridDim.x * gridDim.y * gridDim.z;
    unsigned sum, cnt, mine, sp = 0u;
    for (;;) {
        sum = 0u; cnt = 0u; mine = 0u;
#pragma unroll
        for (unsigned j = 0; j < 16; ++j) { const unsigned c = xb_ld(&bar[XB_XCNT(j)]); sum += c; cnt += (c > 0u) ? 1u : 0u; mine = (j == x) ? c : mine; }
        if (sum == G) break;
        __builtin_amdgcn_s_sleep(1);
        if ((++sp & 255u) == 0u) { if (xb_ld(&bar[XB_TMO])) break; if (sp > XB_SPIN_CAP) { atomicAdd(&bar[XB_TMO], 1u); break; } }
    }
    nloc = mine > 0u ? mine : 1u; nx = cnt > 0u ? cnt : 1u;
}

__device__ __forceinline__ void xcd_barrier(const XcdBarrier& b) {
    asm volatile("s_waitcnt vmcnt(0)" ::: "memory");
    __syncthreads();
    if (threadIdx.x == 0) {
        unsigned* bar = b.bar;
        __builtin_amdgcn_s_waitcnt(0);
        unsigned nloc = b.st[0], nx = b.st[1];
        if (nloc == 0u) { xcd_barrier_complete(bar, b.x, nloc, nx); b.st[0] = nloc; b.st[1] = nx; }
        const unsigned old = xb_add(&bar[XB_XSUB(b.x)], 1u);
        const unsigned gen = old / nloc;
        if (old + 1u == (gen + 1u) * nloc) {
            __builtin_amdgcn_fence(__ATOMIC_RELEASE, "agent");
            asm volatile("s_waitcnt vmcnt(0)" ::: "memory");
            const unsigned og = xb_add(&bar[XB_TOP], 1u);
            const unsigned tg = og / nx;
            if (og + 1u == (tg + 1u) * nx) xb_add(&bar[XB_TOPGEN], 1u);
            else XB_SPIN(xb_ld(&bar[XB_TOPGEN]) == tg, bar);
            __builtin_amdgcn_fence(__ATOMIC_ACQUIRE, "agent");
            xb_add(&bar[XB_XGEN(b.x)], 1u);
            asm volatile("s_waitcnt vmcnt(0)" ::: "memory");
        } else {
            XB_SPIN(xb_ld(&bar[XB_XGEN(b.x)]) == gen, bar);
            __builtin_amdgcn_fence(__ATOMIC_ACQUIRE, "agent");
            asm volatile("s_waitcnt vmcnt(0)" ::: "memory");
        }
    }
    __syncthreads();
}

typedef float f32x16 __attribute__((ext_vector_type(16)));
typedef short s16x4 __attribute__((ext_vector_type(4)));
typedef short v4i16_t __attribute__((ext_vector_type(4)));
typedef unsigned u32x2 __attribute__((ext_vector_type(2)));
typedef float f32x2_t __attribute__((ext_vector_type(2)));
typedef __bf16 bf16x2_t __attribute__((ext_vector_type(2)));

constexpr int NTOK = 32768, SEQ = 4096, DMODEL = 1024, DFF = 4096;
constexpr int LDP = 4864;
constexpr int NPROJ = 5120;
constexpr int INW = 4888;
constexpr float NORM_EPS = 1e-6f;
constexpr size_t MiB = 1u << 20;
constexpr size_t WS_CTL = 0, CTL_ZERO_BYTES = 1 * MiB;
constexpr size_t WS_WIN = 2 * MiB, WS_WUPN = 12 * MiB, WS_WUPM = 13 * MiB, WS_WOUT = 14 * MiB, WS_WFF1 = 16 * MiB, WS_WFF2 = 24 * MiB;
constexpr size_t WS_WC1K = 32 * MiB, WS_WC1V = 32 * MiB + 256 * 1024, WS_ROPE = 32 * MiB + 512 * 1024;
constexpr size_t WS_KC = 33 * MiB, WS_VC = 33 * MiB + 512 * 1024, WS_KMH = 34 * MiB, WS_KML = 34 * MiB + 256 * 1024;
constexpr size_t WS_GN = 35 * MiB;
constexpr size_t WS_QR = 40 * MiB;
constexpr size_t WS_HN = 72 * MiB;
constexpr size_t WS_YN = 72 * MiB, WS_YM = 104 * MiB;
constexpr size_t WS_MIX = 136 * MiB;
constexpr size_t WS_P = 200 * MiB;
constexpr size_t WS_U = 200 * MiB;
constexpr size_t WS_END = 504 * MiB;
constexpr int CW_BAR = 4096;

constexpr int LDS_BYTES = 147456, MISC_OFF = LDS_BYTES - 1024;
constexpr int NWAVES = 8;

__device__ __forceinline__ float bflo(unsigned w) { return __uint_as_float(w << 16); }
__device__ __forceinline__ float bfhi(unsigned w) { return __uint_as_float(w & 0xffff0000u); }
__device__ __forceinline__ unsigned cvtpk_s(float lo, float hi) { f32x2_t v = {lo, hi}; bf16x2_t b = __builtin_convertvector(v, bf16x2_t); return __builtin_bit_cast(unsigned, b); }
__device__ __forceinline__ float wave_sum(float v) {
#pragma unroll
    for (int o = 1; o < 64; o <<= 1) v += __shfl_xor(v, o);
    return v;
}
__device__ __forceinline__ float sigmoidf_(float v) { return 1.0f / (1.0f + __expf(-v)); }

struct EpiProj {
    static constexpr bool PERM = true, AFTER_DRAIN = false;
    bf16* P; bf16* QR; float* GN; const float* rope;
    __device__ __forceinline__ void operator()(const f32x4 (&acc)[2][2][4][2], const pg8::Unit& u, int wr, int wc, int fr, int fq) const {
        const int pn = u.pn; const int row0 = u.pm * 256 + wr * 64 + fr;
        const bool ropelane = ((wc & 1) == 0) && (fq < 2);
#pragma unroll
        for (int bj = 0; bj < 2; ++bj) {
            int mode;
            if (pn < 2) mode = 2; else if (pn == 2) mode = 0; else if (pn <= 4) mode = (bj == 0) ? 1 : 0; else if (pn <= 8) mode = 1; else if (pn <= 10) mode = 0; else if (pn <= 18) mode = 3; else mode = 4;
            const int col = pn * 256 + bj * 128 + wc * 32 + 8 * fq;
#pragma unroll
            for (int ai = 0; ai < 2; ++ai)
#pragma unroll
                for (int m = 0; m < 4; ++m) {
                    const int row = row0 + ai * 128 + m * 16;
                    const f32x4 a0 = acc[ai][bj][m][0], a1 = acc[ai][bj][m][1];
                    float v[8] = {a0[0], a0[1], a0[2], a0[3], a1[0], a1[1], a1[2], a1[3]};
                    if (mode == 1 || mode == 2) {
                        float pv[8], o[8];
#pragma unroll
                        for (int i = 0; i < 8; ++i) { pv[i] = __shfl_xor(v[i], 16); o[i] = v[i]; }
                        if (ropelane) {
                            const float* cs = rope + (size_t)(row & (SEQ - 1)) * 16;
                            const f32x4 c0 = *(const f32x4*)cs, c1 = *(const f32x4*)(cs + 4), s0 = *(const f32x4*)(cs + 8), s1 = *(const f32x4*)(cs + 12);
                            const float c[8] = {c0[0], c0[1], c0[2], c0[3], c1[0], c1[1], c1[2], c1[3]}, s[8] = {s0[0], s0[1], s0[2], s0[3], s1[0], s1[1], s1[2], s1[3]};
#pragma unroll
                            for (int i = 0; i < 8; ++i) o[i] = (fq == 0) ? (v[i] * c[i] - pv[i] * s[i]) : (pv[i] * s[i] + v[i] * c[i]);
                        }
                        if (mode == 2) {
                            v4u w; w.x = cvtpk_s(v[0], v[1]); w.y = cvtpk_s(v[2], v[3]); w.z = cvtpk_s(v[4], v[5]); w.w = cvtpk_s(v[6], v[7]);
                            *(v4u*)(P + (size_t)row * LDP + col) = w;
                            v4u w2; w2.x = cvtpk_s(o[0], o[1]); w2.y = cvtpk_s(o[2], o[3]); w2.z = cvtpk_s(o[4], o[5]); w2.w = cvtpk_s(o[6], o[7]);
                            *(v4u*)(QR + (size_t)row * 512 + col) = w2;
                        } else {
                            v4u w2; w2.x = cvtpk_s(o[0], o[1]); w2.y = cvtpk_s(o[2], o[3]); w2.z = cvtpk_s(o[4], o[5]); w2.w = cvtpk_s(o[6], o[7]);
                            *(v4u*)(P + (size_t)row * LDP + col) = w2;
                        }
                    } else if (mode == 0) {
                        v4u w; w.x = cvtpk_s(v[0], v[1]); w.y = cvtpk_s(v[2], v[3]); w.z = cvtpk_s(v[4], v[5]); w.w = cvtpk_s(v[6], v[7]);
                        *(v4u*)(P + (size_t)row * LDP + col) = w;
                    } else if (mode == 3) {
#pragma unroll
                        for (int i = 0; i < 8; ++i) v[i] = sigmoidf_(v[i]);
                        v4u w; w.x = cvtpk_s(v[0], v[1]); w.y = cvtpk_s(v[2], v[3]); w.z = cvtpk_s(v[4], v[5]); w.w = cvtpk_s(v[6], v[7]);
                        *(v4u*)(P + (size_t)row * LDP + col) = w;
                    } else {
                        if (bj == 0 && wc == 0 && fq < 3) {
                            float* gp = GN + (size_t)row * 32 + 8 * fq;
                            *(f32x4*)gp = (f32x4){sigmoidf_(v[0]), sigmoidf_(v[1]), sigmoidf_(v[2]), sigmoidf_(v[3])};
                            *(f32x4*)(gp + 4) = (f32x4){sigmoidf_(v[4]), sigmoidf_(v[5]), sigmoidf_(v[6]), sigmoidf_(v[7])};
                        }
                    }
                }
        }
    }
};
struct EpiMerge {
    static constexpr bool PERM = true, AFTER_DRAIN = false;
    const bf16* P; bf16* MIX;
    __device__ __forceinline__ void operator()(const f32x4 (&acc)[2][2][4][2], const pg8::Unit& u, int wr, int wc, int fr, int fq) const {
        const int row0 = u.pm * 256 + wr * 64 + fr; const int src = u.src;
#pragma unroll
        for (int ai = 0; ai < 2; ++ai)
#pragma unroll
            for (int m = 0; m < 4; ++m) {
                const int row = row0 + ai * 128 + m * 16;
#pragma unroll
                for (int bj = 0; bj < 2; ++bj) {
                    const int col = u.pn * 256 + bj * 128 + wc * 32 + 8 * fq;
                    const v4u gw = *(const v4u*)(P + (size_t)row * LDP + 2816 + src * 1024 + col);
                    const f32x4 a0 = acc[ai][bj][m][0], a1 = acc[ai][bj][m][1];
                    float r[8] = {a0[0] * bflo(gw.x), a0[1] * bfhi(gw.x), a0[2] * bflo(gw.y), a0[3] * bfhi(gw.y), a1[0] * bflo(gw.z), a1[1] * bfhi(gw.z), a1[2] * bflo(gw.w), a1[3] * bfhi(gw.w)};
                    bf16* mp = MIX + (size_t)row * DMODEL + col;
                    if (src) { const v4u pw = *(const v4u*)mp;
                        r[0] += bflo(pw.x); r[1] += bfhi(pw.x); r[2] += bflo(pw.y); r[3] += bfhi(pw.y); r[4] += bflo(pw.z); r[5] += bfhi(pw.z); r[6] += bflo(pw.w); r[7] += bfhi(pw.w); }
                    v4u w; w.x = cvtpk_s(r[0], r[1]); w.y = cvtpk_s(r[2], r[3]); w.z = cvtpk_s(r[4], r[5]); w.w = cvtpk_s(r[6], r[7]);
                    *(v4u*)mp = w;
                }
            }
    }
};
struct EpiRes {
    static constexpr bool PERM = false, AFTER_DRAIN = false;
    const float* base; float* out;
    __device__ __forceinline__ void operator()(const f32x4 (&acc)[2][2][4][2], const pg8::Unit& u, int wr, int wc, int fr, int fq) const {
        const int row0 = u.pm * 256 + wr * 64 + fr; const int col0 = u.pn * 256 + wc * 32 + 4 * fq;
#pragma unroll
        for (int ai = 0; ai < 2; ++ai)
#pragma unroll
            for (int m = 0; m < 4; ++m) {
                const size_t off = (size_t)(row0 + ai * 128 + m * 16) * DMODEL + col0;
#pragma unroll
                for (int bj = 0; bj < 2; ++bj)
#pragma unroll
                    for (int n = 0; n < 2; ++n) { const f32x4 bs = *(const f32x4*)(base + off + bj * 128 + n * 16); *(f32x4*)(out + off + bj * 128 + n * 16) = bs + acc[ai][bj][m][n]; }
            }
    }
};
struct EpiRelu2 {
    static constexpr bool PERM = true, AFTER_DRAIN = false;
    bf16* U;
    __device__ __forceinline__ void operator()(const f32x4 (&acc)[2][2][4][2], const pg8::Unit& u, int wr, int wc, int fr, int fq) const {
        const int row0 = u.pm * 256 + wr * 64 + fr; const int col0 = u.pn * 256 + wc * 32 + 8 * fq;
#pragma unroll
        for (int ai = 0; ai < 2; ++ai)
#pragma unroll
            for (int m = 0; m < 4; ++m) {
                bf16* rp = U + (size_t)(row0 + ai * 128 + m * 16) * DFF + col0;
#pragma unroll
                for (int bj = 0; bj < 2; ++bj) {
                    f32x4 a0 = acc[ai][bj][m][0], a1 = acc[ai][bj][m][1];
#pragma unroll
                    for (int i = 0; i < 4; ++i) { const float x = fmaxf(a0[i], 0.f), y = fmaxf(a1[i], 0.f); a0[i] = x * x; a1[i] = y * y; }
                    v4u w; w.x = cvtpk_s(a0[0], a0[1]); w.y = cvtpk_s(a0[2], a0[3]); w.z = cvtpk_s(a1[0], a1[1]); w.w = cvtpk_s(a1[2], a1[3]);
                    *(v4u*)(rp + bj * 128) = w;
                }
            }
    }
};

__device__ __forceinline__ int win_src_col(int n) { return n < 1280 ? n : (n < 4864 ? n + 24 : (n < INW ? n - 3584 : -1)); }
__device__ __forceinline__ void transpose_item(const float* W, int K, int N, int Nd, bf16* WT, LAS float* scr, int item, int lane, bool remap) {
    const int nblk = Nd / 32, kb = item / nblk, nb = item % nblk, k0 = 64 * kb, n0 = 32 * nb;
    int sc = n0 + (lane & 31); if (remap) sc = win_src_col(sc);
#pragma unroll 8
    for (int i = 0; i < 32; ++i) { const int kk = 2 * i + (lane >> 5); scr[kk * 33 + (lane & 31)] = sc >= 0 ? W[(size_t)(k0 + kk) * N + sc] : 0.f; }
    LDS_WAIT(); asm volatile("" ::: "memory");
    const int c = lane & 7;
#pragma unroll
    for (int j = 0; j < 4; ++j) { const int n = (lane >> 3) + 8 * j; const LAS float* s = scr + (8 * c) * 33 + n;
        v4u o; o.x = pk2(s[0 * 33], s[1 * 33]); o.y = pk2(s[2 * 33], s[3 * 33]); o.z = pk2(s[4 * 33], s[5 * 33]); o.w = pk2(s[6 * 33], s[7 * 33]);
        *(GAS v4u*)(WT + (size_t)(n0 + n) * K + k0 + 8 * c) = o; }
    LDS_WAIT(); asm volatile("" ::: "memory");
}
template <bool OUTF32> __device__ __forceinline__ void rms_row(const float* xrow, const float* g, void* orow, int lane) {
    const f32x4* xr = (const f32x4*)xrow + lane; const f32x4* gr = (const f32x4*)g + lane;
    f32x4 v[4]; float s = 0.f;
#pragma unroll
    for (int j = 0; j < 4; ++j) { v[j] = xr[64 * j]; s += (v[j].x * v[j].x + v[j].y * v[j].y) + (v[j].z * v[j].z + v[j].w * v[j].w); }
    const float rstd = 1.0f / sqrtf(wave_sum(s) * (1.0f / DMODEL) + NORM_EPS);
#pragma unroll
    for (int j = 0; j < 4; ++j) { const f32x4 gg = gr[64 * j]; const f32x4 o = v[j] * rstd * gg;
        if (OUTF32) ((f32x4*)orow + lane)[64 * j] = o;
        else ((u32x2*)orow + lane)[64 * j] = (u32x2){cvtpk_s(o.x, o.y), cvtpk_s(o.z, o.w)}; }
}

namespace att {
constexpr float C2 = 0.125f * 1.4426950408889634f;
__device__ __forceinline__ int crow(int r, int hi) { return (r & 3) + 8 * (r >> 2) + 4 * hi; }
__device__ __forceinline__ float pmax(float v) { auto rr = __builtin_amdgcn_permlane32_swap(__float_as_uint(v), __float_as_uint(v), false, false); return fmaxf(__uint_as_float(rr[0]), __uint_as_float(rr[1])); }
__device__ __forceinline__ float psum(float v) { auto rr = __builtin_amdgcn_permlane32_swap(__float_as_uint(v), __float_as_uint(v), false, false); return __uint_as_float(rr[0]) + __uint_as_float(rr[1]); }
__device__ __forceinline__ void stage_kv(LAS unsigned char* lds, int koff, int voff, const bf16* Kt, const bf16* Vt, int pitch, int wid, int lane) {
    const unsigned ko = (unsigned)(lane * pitch + wid * 8), vo = (unsigned)((16 * (wid & 3) + (lane >> 2)) * pitch + (wid >> 2) * 32 + (lane & 3) * 8);
    const bf16* ks = Kt + ko; const bf16* vs = Vt + vo;
    __builtin_amdgcn_global_load_lds((const unsigned*)ks, (LAS unsigned*)(lds + koff + wid * 1024), 16, 0, 0);
    __builtin_amdgcn_global_load_lds((const unsigned*)vs, (LAS unsigned*)(lds + voff + wid * 1024), 16, 0, 0);
}
__device__ __forceinline__ void qkt(f32x16& p0, f32x16& p1, LAS const unsigned char* kslot, const bf16x8 (&q)[4], const f32x16& init, int r32, int hi) {
    LAS const unsigned char* kb = kslot + hi * 1024 + r32 * 16;
#pragma unroll
    for (int d0 = 0; d0 < 4; ++d0) {
        const bf16x8 b0 = *(LAS const bf16x8*)(kb + d0 * 2048);
        const bf16x8 b1 = *(LAS const bf16x8*)(kb + d0 * 2048 + 512);
        if (d0 == 0) { p0 = __builtin_amdgcn_mfma_f32_32x32x16_bf16(b0, q[0], init, 0, 0, 0); p1 = __builtin_amdgcn_mfma_f32_32x32x16_bf16(b1, q[0], init, 0, 0, 0); }
        else { p0 = __builtin_amdgcn_mfma_f32_32x32x16_bf16(b0, q[d0], p0, 0, 0, 0); p1 = __builtin_amdgcn_mfma_f32_32x32x16_bf16(b1, q[d0], p1, 0, 0, 0); }
    }
}
__device__ __forceinline__ s16x4 vtr(LAS const unsigned char* p) { return __builtin_bit_cast(s16x4, __builtin_amdgcn_ds_read_tr16_b64_v4i16((LAS v4i16_t*)p)); }
__device__ __forceinline__ void pv(f32x16 (&o)[2], LAS const unsigned char* vp, const bf16x8 (&pa)[4]) {
#pragma unroll
    for (int d0 = 0; d0 < 2; ++d0)
#pragma unroll
        for (int ks = 0; ks < 4; ++ks) {
            const s16x4 lo = vtr(vp + d0 * 4096 + ks * 1024), h4 = vtr(vp + d0 * 4096 + ks * 1024 + 512);
            const bf16x8 vf = {lo[0], lo[1], lo[2], lo[3], h4[0], h4[1], h4[2], h4[3]};
            o[d0] = __builtin_amdgcn_mfma_f32_32x32x16_bf16(vf, pa[ks], o[d0], 0, 0, 0);
            if (ks == 3) __builtin_amdgcn_sched_barrier(0);
        }
}
__device__ __forceinline__ void pack_p(bf16x8 (&pa)[4], const f32x16& p0, const f32x16& p1) {
    const v4u w0 = {cvtpk_s(p0[0], p0[1]), cvtpk_s(p0[2], p0[3]), cvtpk_s(p0[4], p0[5]), cvtpk_s(p0[6], p0[7])};
    const v4u w1 = {cvtpk_s(p0[8], p0[9]), cvtpk_s(p0[10], p0[11]), cvtpk_s(p0[12], p0[13]), cvtpk_s(p0[14], p0[15])};
    const v4u w2 = {cvtpk_s(p1[0], p1[1]), cvtpk_s(p1[2], p1[3]), cvtpk_s(p1[4], p1[5]), cvtpk_s(p1[6], p1[7])};
    const v4u w3 = {cvtpk_s(p1[8], p1[9]), cvtpk_s(p1[10], p1[11]), cvtpk_s(p1[12], p1[13]), cvtpk_s(p1[14], p1[15])};
    pa[0] = __builtin_bit_cast(bf16x8, w0); pa[1] = __builtin_bit_cast(bf16x8, w1); pa[2] = __builtin_bit_cast(bf16x8, w2); pa[3] = __builtin_bit_cast(bf16x8, w3);
}
__device__ __forceinline__ void mask_gt(f32x16& p0, f32x16& p1, int lim, int hi) {
#pragma unroll
    for (int r = 0; r < 16; ++r) { const int kk = crow(r, hi); if (kk > lim) p0[r] = -INFINITY; if (kk + 32 > lim) p1[r] = -INFINITY; }
}
__device__ __forceinline__ void mask_le(f32x16& p0, f32x16& p1, int lim, int hi) {
#pragma unroll
    for (int r = 0; r < 16; ++r) { const int kk = crow(r, hi); if (kk <= lim) p0[r] = -INFINITY; if (kk + 32 <= lim) p1[r] = -INFINITY; }
}
__device__ __forceinline__ float tile_max(const f32x16& p0, const f32x16& p1) {
    float rm = fmaxf(p0[0], p1[0]);
#pragma unroll
    for (int r = 1; r < 16; ++r) rm = fmaxf(rm, fmaxf(p0[r], p1[r]));
    return rm;
}
__device__ __forceinline__ void soft_step(f32x16& p0, f32x16& p1, float bias  , float& m, float& l, f32x16 (&o)[2], LAS const unsigned char* vp) {
    const float rm = pmax(tile_max(p0, p1) + bias);
    const float mn = fmaxf(m, rm);
    if (__any(mn > m)) { const float a = __builtin_amdgcn_exp2f((m - mn) * C2); l *= a; o[0] *= a; o[1] *= a; }
    m = mn;
    const float mc = -mn * C2 + bias; float s = 0.f;
#pragma unroll
    for (int r = 0; r < 16; ++r) { p0[r] = __builtin_amdgcn_exp2f(fmaf(p0[r], C2, mc)); p1[r] = __builtin_amdgcn_exp2f(fmaf(p1[r], C2, mc)); s += p0[r] + p1[r]; }
    l += s;
    bf16x8 pa[4]; pack_p(pa, p0, p1);
    pv(o, vp, pa);
}
__device__ __forceinline__ void fin_add(f32x16 (&y)[2], const f32x16 (&o)[2], float l, float gate) {
    const float lt = psum(l); const float sc = lt > 0.f ? gate / lt : 0.f;
    y[0] += o[0] * sc; y[1] += o[1] * sc;
}
__device__ __forceinline__ void store_y(bf16* yrow, const f32x16 (&y)[2], int hi) {
#pragma unroll
    for (int d0 = 0; d0 < 2; ++d0)
#pragma unroll
        for (int rg = 0; rg < 4; ++rg) {
            const u32x2 w = {cvtpk_s(y[d0][4 * rg], y[d0][4 * rg + 1]), cvtpk_s(y[d0][4 * rg + 2], y[d0][4 * rg + 3])};
            *(u32x2*)(yrow + 32 * d0 + 8 * rg + 4 * hi) = w;
        }
}
__device__ __forceinline__ int next_set(unsigned long long um, int from) { if (from >= 64) return 64; const unsigned long long x = um >> from; return x ? from + __builtin_ctzll(x) : 64; }

__device__ __forceinline__ void nsa_item(LAS unsigned char* lds, const bf16* P, const bf16* QR, const float* GN, const bf16* KC, const bf16* VC, bf16* YN,
                                         int b, int g, int tb, int wid, int lane_in, int tid_in) {
    int lane = lane_in, tid = tid_in; asm volatile("" : "+v"(lane), "+v"(tid));
    const int r = wid & 3, ts = wid >> 2, h = 4 * g + r, r32 = lane & 31, hi = lane >> 5;
    const int tq = 32 * ts + r32, t = 64 * tb + tq; const size_t row = (size_t)b * SEQ + t;
    const float g0 = GN[row * 32 + 3 * h], g1 = GN[row * 32 + 3 * h + 1], g2 = GN[row * 32 + 3 * h + 2];
    LAS unsigned* maskw = (LAS unsigned*)(lds + MISC_OFF + 256);
    LAS unsigned* uni = (LAS unsigned*)(lds + MISC_OFF + 768);
    const int vpo = ((lane >> 4) & 1) * 32 + (lane & 3) * 8 + (4 * hi + ((lane & 15) >> 2)) * 64;
    const f32x16 zero16 = {0.f, 0.f, 0.f, 0.f, 0.f, 0.f, 0.f, 0.f, 0.f, 0.f, 0.f, 0.f, 0.f, 0.f, 0.f, 0.f};
    f32x16 y[2] = {zero16, zero16};
    if (tid < 128) maskw[tid] = 0u;
    if (tid == 128) { uni[0] = 0u; uni[1] = 0u; }
    __syncthreads();
    const int ntc = ((4 * tb + 2) >> 6) + 1;
    {
        bf16x8 qc[4];
#pragma unroll
        for (int d0 = 0; d0 < 4; ++d0) qc[d0] = *(const bf16x8*)(P + row * LDP + 64 * h + 16 * d0 + 8 * hi);
        const bf16* kcb = KC + (size_t)(b * 2 + g) * 256 * 64; const bf16* vcb = VC + (size_t)(b * 2 + g) * 256 * 64;
#pragma unroll 1
        for (int T = 0; T < ntc; ++T) stage_kv(lds, T * 8192, 32768 + T * 8192, kcb + (size_t)T * 64 * 64, vcb + (size_t)T * 64 * 64, 64, wid, lane);
        __syncthreads();
        const int nlim = t >= 31 ? ((t - 31) >> 4) : -1;
        float m = -1e30f;
#pragma unroll 1
        for (int T = 0; T < ntc; ++T) { f32x16 p0, p1; qkt(p0, p1, lds + T * 8192, qc, zero16, r32, hi); mask_gt(p0, p1, nlim - 64 * T, hi); m = fmaxf(m, tile_max(p0, p1)); }
        m = pmax(m);
        const float mc = -m * C2; float l = 0.f; f32x16 o[2] = {zero16, zero16};
        float carry = 0.f;
        LAS float* Fb = (LAS float*)(lds + 65536) + (wid * 32 + r32) * 65 + hi;
#pragma unroll 1
        for (int T = 0; T < ntc; ++T) {
            f32x16 p0, p1; qkt(p0, p1, lds + T * 8192, qc, zero16, r32, hi); mask_gt(p0, p1, nlim - 64 * T, hi);
            float s = 0.f;
#pragma unroll
            for (int rr = 0; rr < 16; ++rr) { p0[rr] = __builtin_amdgcn_exp2f(fmaf(p0[rr], C2, mc)); p1[rr] = __builtin_amdgcn_exp2f(fmaf(p1[rr], C2, mc)); s += p0[rr] + p1[rr]; }
            l += s;
#pragma unroll
            for (int ph = 0; ph < 2; ++ph)
#pragma unroll
                for (int i = 0; i < 4; ++i) {
                    const float e0 = ph ? p1[4 * i] : p0[4 * i], e1 = ph ? p1[4 * i + 1] : p0[4 * i + 1], e2 = ph ? p1[4 * i + 2] : p0[4 * i + 2], e3 = ph ? p1[4 * i + 3] : p0[4 * i + 3];
                    const float Lr = __shfl_xor(e3, 32);
                    Fb[16 * T + 8 * ph + 2 * i] = ((e0 + e1) + (e2 + e3)) + (hi ? Lr : carry);
                    carry = Lr;
                }
            bf16x8 pa[4]; pack_p(pa, p0, p1);
            pv(o, lds + 32768 + T * 8192 + vpo, pa);
        }
        const float lt = psum(l); const float inv = lt > 0.f ? 1.0f / lt : 0.f;
        y[0] = o[0] * (g0 * inv); y[1] = o[1] * (g0 * inv);
        if (hi == 0) ((LAS float*)(lds + 65536 + 66560))[wid * 32 + r32] = inv;
    }
    __syncthreads();
    {
        const int tk = tid >> 3, sub = tid & 7;
        LAS const float* F0 = (LAS const float*)(lds + 65536) + ((tk >> 5) * 128 + (tk & 31)) * 65;
        LAS float* imp = (LAS float*)lds + tk * 65;
        LAS const float* ivp = (LAS const float*)(lds + 65536 + 66560) + (tk >> 5) * 128 + (tk & 31);
        const float iv0 = ivp[0], iv1 = ivp[32], iv2 = ivp[64], iv3 = ivp[96];
#pragma unroll
        for (int i = 0; i < 8; ++i) { const int j = 8 * sub + i;
            float v = ((F0[j] * iv0 + F0[32 * 65 + j] * iv1) + F0[64 * 65 + j] * iv2) + F0[96 * 65 + j] * iv3;
            if (j == 0 || j == tb || j == tb - 1) v = INFINITY;
            if (j > tb) v = -INFINITY;
            imp[j] = v; }
        __syncthreads();
        unsigned bits = 0u;
#pragma unroll
        for (int i = 0; i < 8; ++i) { const int j = 8 * sub + i; const float vj = imp[j]; int rank = 0;
#pragma unroll 1
            for (int jj = 0; jj < 64; ++jj) { const float vv = imp[jj]; rank += (vv > vj || (vv == vj && jj < j)) ? 1 : 0; }
            if (rank < 16 && j <= tb) bits |= 1u << i; }
        bits <<= 8 * (sub & 3);
        __hip_atomic_fetch_or(maskw + 2 * tk + (sub >> 2), bits, __ATOMIC_RELAXED, __HIP_MEMORY_SCOPE_WORKGROUP);
        __hip_atomic_fetch_or(uni + (sub >> 2), bits, __ATOMIC_RELAXED, __HIP_MEMORY_SCOPE_WORKGROUP);
        __syncthreads();
    }
    const unsigned long long mymask = ((unsigned long long)maskw[2 * tq + 1] << 32) | maskw[2 * tq];
    const unsigned long long um = ((unsigned long long)(unsigned)__builtin_amdgcn_readfirstlane((int)uni[1]) << 32) | (unsigned)__builtin_amdgcn_readfirstlane((int)uni[0]);
    const size_t brow = (size_t)b * SEQ;
    bf16x8 qr[4];
#pragma unroll
    for (int d0 = 0; d0 < 4; ++d0) qr[d0] = *(const bf16x8*)(QR + row * 512 + 64 * h + 16 * d0 + 8 * hi);
    {
        const bf16* Kb = P + brow * LDP + 768 + 64 * g; const bf16* Vb = P + brow * LDP + 896 + 64 * g;
        float ms = -1e30f, l = 0.f; f32x16 o[2] = {zero16, zero16};
        int j = next_set(um, 0), buf = 0;
        if (j <= tb) stage_kv(lds, 0, 16384, Kb + (size_t)(64 * j) * LDP, Vb + (size_t)(64 * j) * LDP, LDP, wid, lane);
        while (j <= tb) {
            __syncthreads();
            const int jn = next_set(um, j + 1);
            if (jn <= tb) stage_kv(lds, (buf ^ 1) * 8192, 16384 + (buf ^ 1) * 8192, Kb + (size_t)(64 * jn) * LDP, Vb + (size_t)(64 * jn) * LDP, LDP, wid, lane);
            const float iv = ((mymask >> j) & 1ull) ? 0.f : -INFINITY;
            f32x16 p0, p1; qkt(p0, p1, lds + buf * 8192, qr, zero16, r32, hi);
            if (j == tb) mask_gt(p0, p1, tq, hi);
            soft_step(p0, p1, iv, ms, l, o, lds + 16384 + buf * 8192 + vpo);
            j = jn; buf ^= 1;
        }
        fin_add(y, o, l, g1);
    }
    {
        const bf16* Kb = P + brow * LDP + 1024 + 64 * g; const bf16* Vb = P + brow * LDP + 1152 + 64 * g;
        float mw = -1e30f, l = 0.f; f32x16 o[2] = {zero16, zero16};
        const int j0 = tb >= 8 ? tb - 8 : 0; int buf = 0;
        __syncthreads();
        stage_kv(lds, 0, 16384, Kb + (size_t)(64 * j0) * LDP, Vb + (size_t)(64 * j0) * LDP, LDP, wid, lane);
        for (int j = j0; j <= tb; ++j) {
            __syncthreads();
            if (j + 1 <= tb) stage_kv(lds, (buf ^ 1) * 8192, 16384 + (buf ^ 1) * 8192, Kb + (size_t)(64 * (j + 1)) * LDP, Vb + (size_t)(64 * (j + 1)) * LDP, LDP, wid, lane);
            f32x16 p0, p1; qkt(p0, p1, lds + buf * 8192, qr, zero16, r32, hi);
            if (j == tb) mask_gt(p0, p1, tq, hi);
            if (tb >= 8 && j == tb - 8) mask_le(p0, p1, tq, hi);
            soft_step(p0, p1, 0.f, mw, l, o, lds + 16384 + buf * 8192 + vpo);
            buf ^= 1;
        }
        fin_add(y, o, l, g2);
    }
    store_y(YN + row * 512 + 64 * h, y, hi);
}

__device__ __forceinline__ void moba_item(LAS unsigned char* lds, const bf16* P, const bf16* KMH, const bf16* KML, bf16* YM, int b, int h, int ob, int wid, int lane_in, int tid_in) {
    int lane = lane_in, tid = tid_in; asm volatile("" : "+v"(lane), "+v"(tid));
    const int r32 = lane & 31, hi = lane >> 5, tq = 32 * wid + r32, t = 256 * ob + tq; const size_t row = (size_t)b * SEQ + t;
    bf16x8 qr[4];
#pragma unroll
    for (int d0 = 0; d0 < 4; ++d0) qr[d0] = *(const bf16x8*)(P + row * LDP + 1280 + 64 * h + 16 * d0 + 8 * hi);
    LAS unsigned* uni = (LAS unsigned*)(lds + MISC_OFF + 776);
    const int vpo = ((lane >> 4) & 1) * 32 + (lane & 3) * 8 + (4 * hi + ((lane & 15) >> 2)) * 64;
    const f32x16 zero16 = {0.f, 0.f, 0.f, 0.f, 0.f, 0.f, 0.f, 0.f, 0.f, 0.f, 0.f, 0.f, 0.f, 0.f, 0.f, 0.f};
    if (tid == 0) uni[0] = 0u;
    __syncthreads();
    unsigned mymask = 0u;
    if (ob > 0) {
        f32x16 ga = zero16;
        const bf16* kh = KMH + ((size_t)(b * 8 + h) * 16 + (r32 & 15)) * 64 + 8 * hi; const bf16* kl = KML + ((size_t)(b * 8 + h) * 16 + (r32 & 15)) * 64 + 8 * hi;
#pragma unroll
        for (int d0 = 0; d0 < 4; ++d0) { const bf16x8 ah = *(const bf16x8*)(kh + 16 * d0), al = *(const bf16x8*)(kl + 16 * d0);
            ga = __builtin_amdgcn_mfma_f32_32x32x16_bf16(ah, qr[d0], ga, 0, 0, 0); ga = __builtin_amdgcn_mfma_f32_32x32x16_bf16(al, qr[d0], ga, 0, 0, 0); }
        float gv[16];
#pragma unroll
        for (int rr = 0; rr < 8; ++rr) { const float a = ga[rr], bb = __shfl_xor(a, 32); const int n0 = (rr & 3) + 8 * (rr >> 2); gv[n0] = hi ? bb : a; gv[n0 + 4] = hi ? a : bb; }
#pragma unroll
        for (int pick = 0; pick < 3; ++pick) { float best = -INFINITY; int bi = -1;
#pragma unroll
            for (int n = 0; n < 16; ++n) if (n < ob && !((mymask >> n) & 1u) && gv[n] > best) { best = gv[n]; bi = n; }
            if (bi >= 0) mymask |= 1u << bi; }
        unsigned umw = 0u;
#pragma unroll
        for (int n = 0; n < 16; ++n) if (__ballot((mymask >> n) & 1u)) umw |= 1u << n;
        if (lane == 0) __hip_atomic_fetch_or(uni, umw, __ATOMIC_RELAXED, __HIP_MEMORY_SCOPE_WORKGROUP);
    }
    __syncthreads();
    const unsigned um = (unsigned)__builtin_amdgcn_readfirstlane((int)uni[0]);
    const size_t brow = (size_t)b * SEQ;
    const bf16* Kb = P + brow * LDP + 1792 + 64 * h; const bf16* Vb = P + brow * LDP + 2304 + 64 * h;
    float m = -1e30f, l = 0.f; f32x16 o[2] = {zero16, zero16};
    const int ntile = 4 + 4 * ob;
    int x = 0, buf = 0;
    stage_kv(lds, 0, 16384, Kb + (size_t)(256 * ob) * LDP, Vb + (size_t)(256 * ob) * LDP, LDP, wid, lane);
    while (x < ntile) {
        __syncthreads();
        int xn = x + 1;
        while (xn < ntile && xn >= 4 && !((um >> ((xn - 4) >> 2)) & 1u)) xn += 4 - ((xn - 4) & 3);
        if (xn < ntile) { const int blk = xn < 4 ? ob : ((xn - 4) >> 2), kt = xn < 4 ? xn : ((xn - 4) & 3); const size_t key0 = (size_t)(256 * blk + 64 * kt);
            stage_kv(lds, (buf ^ 1) * 8192, 16384 + (buf ^ 1) * 8192, Kb + key0 * LDP, Vb + key0 * LDP, LDP, wid, lane); }
        const bool own = x < 4; const int blk = own ? ob : ((x - 4) >> 2), kt = own ? x : ((x - 4) & 3);
        const bool skipwave = own && (64 * kt > 32 * wid + 31);
        if (!skipwave) {
            const float iv = own ? 0.f : (((mymask >> blk) & 1u) ? 0.f : -INFINITY);
            f32x16 p0, p1; qkt(p0, p1, lds + buf * 8192, qr, zero16, r32, hi);
            if (own && (64 * kt + 63 > 32 * wid)) mask_gt(p0, p1, tq - 64 * kt, hi);
            soft_step(p0, p1, iv, m, l, o, lds + 16384 + buf * 8192 + vpo);
        }
        x = xn; buf ^= 1;
    }
    f32x16 y[2] = {zero16, zero16};
    fin_add(y, o, l, 1.0f);
    store_y(YM + row * 512 + 64 * h, y, hi);
}
}

__device__ __forceinline__ float gelu_tanh(float x) { const float y = 0.7978845608028654f * (x + 0.044715f * x * x * x); const float e = __expf(2.f * y); const float th = 1.f - 2.f / (e + 1.f); return 0.5f * x * (1.f + th); }
__device__ __forceinline__ void compress_item(LAS unsigned char* lds, const bf16* P, const bf16* W1T, const float* pe, const float* w1, const float* w2, bf16* OUT, int kv, int b, int g, int rt, int wid, int lane, int tid) {
    LAS float* part = (LAS float*)lds;
    LAS float* Hs = (LAS float*)(lds + 65536);
    LAS float* biasp = (LAS float*)(lds + 65536 + 8192);
    const int r32 = lane & 31, hi = lane >> 5;
    __syncthreads();
    {
        const int n = tid & 63, pt = tid >> 6; float s = 0.f;
        for (int k = 256 * pt; k < 256 * pt + 256; ++k) s += pe[k] * w1[(size_t)k * 64 + n];
        biasp[pt * 64 + n] = s;
    }
    const bf16* Asrc = P + (size_t)b * SEQ * LDP + 512 + 128 * kv + 64 * g;
    const int rowi = rt * 32 + r32, rowc = rowi < 255 ? rowi : 254;
    f32x16 c0 = {0.f, 0.f, 0.f, 0.f, 0.f, 0.f, 0.f, 0.f, 0.f, 0.f, 0.f, 0.f, 0.f, 0.f, 0.f, 0.f}, c1 = c0;
#pragma unroll 4
    for (int ks = 0; ks < 16; ++ks) {
        const int l = wid * 4 + (ks >> 2), d = (ks & 3) * 16 + 8 * hi, k = wid * 256 + ks * 16 + 8 * hi;
        const bf16x8 a = *(const bf16x8*)(Asrc + (size_t)(16 * rowc + l) * LDP + d);
        const bf16x8 b0 = *(const bf16x8*)(W1T + (size_t)r32 * 2048 + k), b1 = *(const bf16x8*)(W1T + (size_t)(32 + r32) * 2048 + k);
        c0 = __builtin_amdgcn_mfma_f32_32x32x16_bf16(a, b0, c0, 0, 0, 0); c1 = __builtin_amdgcn_mfma_f32_32x32x16_bf16(a, b1, c1, 0, 0, 0);
    }
#pragma unroll
    for (int r = 0; r < 16; ++r) { const int i = att::crow(r, hi); part[(wid * 32 + i) * 64 + r32] = c0[r]; part[(wid * 32 + i) * 64 + 32 + r32] = c1[r]; }
    __syncthreads();
#pragma unroll
    for (int jj = 0; jj < 4; ++jj) { const int e = tid + 512 * jj, n = e & 63; float s = 0.f, bs = 0.f;
#pragma unroll
        for (int w = 0; w < 8; ++w) { s += part[w * 2048 + e]; bs += biasp[w * 64 + n]; }
        Hs[e] = gelu_tanh(s + bs); }
    __syncthreads();
#pragma unroll
    for (int jj = 0; jj < 4; ++jj) { const int e = tid + 512 * jj, i = e >> 6, c = e & 63; float s = 0.f;
        for (int j = 0; j < 64; ++j) s += Hs[i * 64 + j] * w2[j * 64 + c];
        const int ro = rt * 32 + i;
        OUT[((size_t)(b * 2 + g) * 256 + ro) * 64 + c] = (ro < 255) ? (bf16)f2bf(s) : (bf16)0; }
}
__device__ __forceinline__ void kmean_item(const bf16* P, bf16* KMH, bf16* KML, int b, int n, int tid) {
    const bf16* src = P + ((size_t)b * SEQ + 256 * n) * LDP + 1792 + tid; float s = 0.f;
#pragma unroll 8
    for (int i = 0; i < 256; ++i) s += __uint_as_float((unsigned)src[(size_t)i * LDP] << 16);
    s *= (1.0f / 256.0f);
    const unsigned hb = f2bf(s); const float hf = __uint_as_float(hb << 16);
    const int h = tid >> 6, d = tid & 63; const size_t o = ((size_t)(b * 8 + h) * 16 + n) * 64 + d;
    KMH[o] = (bf16)hb; KML[o] = (bf16)f2bf(s - hf);
}

#ifndef MK_PH
#define MK_PH 0x3ff
#endif
struct Args { const float* in[16]; float* out; unsigned char* ws; };
#ifndef MK_SKIP_NSA
#define MK_SKIP_NSA 0
#endif
#ifndef MK_SKIP_MOBA
#define MK_SKIP_MOBA 0
#endif
__global__ void __launch_bounds__(NWAVES * 64, 2) mega_fwd(Args a) {
    extern __shared__ __attribute__((aligned(16))) unsigned char lds_raw[];
    LAS unsigned char* lds = (LAS unsigned char*)lds_raw;
    const int tid = threadIdx.x, lane = tid & 63, wave = __builtin_amdgcn_readfirstlane(tid >> 6);
    const int G = gridDim.x, bx = blockIdx.x; const int vcu = (G % 8 == 0) ? (bx % 8) * (G / 8) + bx / 8 : bx;
    unsigned char* ws = a.ws;
    const float* x = a.in[0]; const float* norm1_g = a.in[1]; const float* w_in = a.in[2]; const float* pe_k = a.in[3]; const float* pe_v = a.in[4];
    const float* ck_w1 = a.in[5]; const float* ck_w2 = a.in[6]; const float* cv_w1 = a.in[7]; const float* cv_w2 = a.in[8];
    const float* w_upn = a.in[9]; const float* w_upm = a.in[10]; const float* w_out = a.in[11]; const float* norm2_g = a.in[12];
    const float* w_ff1 = a.in[13]; const float* w_ff2 = a.in[14]; const float* normf_g = a.in[15];
    float* out = a.out;
    bf16* WIN = (bf16*)(ws + WS_WIN); bf16* WUPN = (bf16*)(ws + WS_WUPN); bf16* WUPM = (bf16*)(ws + WS_WUPM); bf16* WOUT = (bf16*)(ws + WS_WOUT);
    bf16* WFF1 = (bf16*)(ws + WS_WFF1); bf16* WFF2 = (bf16*)(ws + WS_WFF2); bf16* WC1K = (bf16*)(ws + WS_WC1K); bf16* WC1V = (bf16*)(ws + WS_WC1V);
    float* ROPE = (float*)(ws + WS_ROPE); bf16* KC = (bf16*)(ws + WS_KC); bf16* VC = (bf16*)(ws + WS_VC); bf16* KMH = (bf16*)(ws + WS_KMH); bf16* KML = (bf16*)(ws + WS_KML);
    float* GN = (float*)(ws + WS_GN); bf16* QR = (bf16*)(ws + WS_QR); bf16* HN = (bf16*)(ws + WS_HN); bf16* YN = (bf16*)(ws + WS_YN); bf16* YM = (bf16*)(ws + WS_YM);
    bf16* MIX = (bf16*)(ws + WS_MIX); bf16* P = (bf16*)(ws + WS_P); bf16* U = (bf16*)(ws + WS_U);
    gu32* ctl = (gu32*)(ws + WS_CTL);

    for (int u = tid; u < (LDS_BYTES - MISC_OFF) / 4; u += NWAVES * 64) ((LAS unsigned*)(lds + MISC_OFF))[u] = 0u;
    __syncthreads();
    XcdBarrier bar = xcd_barrier_post((unsigned*)(ctl + CW_BAR), (volatile LAS unsigned*)(lds + MISC_OFF) + 8);

#if (MK_PH >> 0) & 1
    {
        LAS float* scr = (LAS float*)(lds + wave * 16384);
        const int gw = vcu * NWAVES + wave, NGW = G * NWAVES;
        constexpr int I_WIN = 16 * 160, I_UP = 8 * 32, I_OUT = 16 * 32, I_FF1 = 16 * 128, I_FF2 = 64 * 32, I_C1 = 32 * 2;
        constexpr int NITEMS = I_WIN + 2 * I_UP + I_OUT + I_FF1 + I_FF2 + 2 * I_C1;
        for (int it = gw; it < NITEMS; it += NGW) {
            int r = it;
            if (r < I_WIN) { transpose_item(w_in, 1024, INW, NPROJ, WIN, scr, r, lane, true); continue; } r -= I_WIN;
            if (r < I_UP) { transpose_item(w_upn, 512, 1024, 1024, WUPN, scr, r, lane, false); continue; } r -= I_UP;
            if (r < I_UP) { transpose_item(w_upm, 512, 1024, 1024, WUPM, scr, r, lane, false); continue; } r -= I_UP;
            if (r < I_OUT) { transpose_item(w_out, 1024, 1024, 1024, WOUT, scr, r, lane, false); continue; } r -= I_OUT;
            if (r < I_FF1) { transpose_item(w_ff1, 1024, 4096, 4096, WFF1, scr, r, lane, false); continue; } r -= I_FF1;
            if (r < I_FF2) { transpose_item(w_ff2, 4096, 1024, 1024, WFF2, scr, r, lane, false); continue; } r -= I_FF2;
            if (r < I_C1) { transpose_item(ck_w1, 2048, 64, 64, WC1K, scr, r, lane, false); continue; } r -= I_C1;
            transpose_item(cv_w1, 2048, 64, 64, WC1V, scr, r, lane, false);
        }
        for (int idx = gw * 64 + lane; idx < SEQ * 8; idx += NGW * 64) {
            const int pos = idx >> 3, i = idx & 7;
            const float inv = powf(500000.0f, -(float)i * 0.125f), ang = (float)pos * inv;
            ROPE[pos * 16 + i] = cosf(ang); ROPE[pos * 16 + 8 + i] = sinf(ang);
        }
        for (int m = gw; m < NTOK; m += NGW) rms_row<false>(x + (size_t)m * DMODEL, norm1_g, HN + (size_t)m * DMODEL, lane);
    }
    xcd_barrier(bar);

#endif
#if (MK_PH >> 1) & 1
    {
        pg8::Gemm g{HN, WIN, HN, WIN, NTOK, NPROJ, DMODEL}; pg8::StaticOrder S; S.init(NTOK, NPROJ, G, bx);
        EpiProj E{P, QR, GN, ROPE};
        pg8::gemm_phase<EpiProj, pg8::StaticOrder, true, true>(lds, g, S, E);
    }
    xcd_barrier(bar);

#endif
#if (MK_PH >> 2) & 1
    for (int it = vcu; it < 256; it += G) {
        const int kv = it >> 7, b = (it >> 4) & 7, g = (it >> 3) & 1, rt = it & 7;
        compress_item(lds, P, kv ? WC1V : WC1K, kv ? pe_v : pe_k, kv ? cv_w1 : ck_w1, kv ? cv_w2 : ck_w2, kv ? VC : KC, kv, b, g, rt, wave, lane, tid);
    }
    for (int it = vcu; it < 128; it += G) kmean_item(P, KMH, KML, it >> 4, it & 15, tid);
    xcd_barrier(bar);

#endif
#if (MK_PH >> 3) & 1
    {
#if MK_SKIP_NSA
        for (size_t i = (size_t)bx * 512 + tid; i < (size_t)NTOK * 512 / 8; i += (size_t)G * 512) ((v4u*)YN)[i] = (v4u){0u, 0u, 0u, 0u};
#else
        for (int it = vcu; it < 256; it += G) {
            const int bg = it >> 4, s = it & 15;
#pragma unroll 1
            for (int k = 0; k < 4; ++k) { const int tb = (k == 0) ? 63 - s : (k == 1) ? 32 + s : (k == 2) ? 31 - s : s;
                att::nsa_item(lds, P, QR, GN, KC, VC, YN, bg >> 1, bg & 1, tb, wave, lane, tid); }
        }
#endif
#if MK_SKIP_MOBA
        for (size_t i = (size_t)bx * 512 + tid; i < (size_t)NTOK * 512 / 8; i += (size_t)G * 512) ((v4u*)YM)[i] = (v4u){0u, 0u, 0u, 0u};
#else
        for (int it = vcu; it < 256; it += G) {
            const int bh = it >> 2, s = it & 3;
#pragma unroll 1
            for (int k = 0; k < 4; ++k) { const int ob = (k == 0) ? 15 - s : (k == 1) ? 8 + s : (k == 2) ? 7 - s : s;
                att::moba_item(lds, P, KMH, KML, YM, bh >> 3, bh & 7, ob, wave, lane, tid); }
        }
#endif
    }
    xcd_barrier(bar);

#endif
#if (MK_PH >> 4) & 1
    {
        pg8::Gemm g{YN, WUPN, YM, WUPM, NTOK, DMODEL, 512}; pg8::PairOrder S; S.init(NTOK, DMODEL, G, bx);
        EpiMerge E{P, MIX};
        pg8::gemm_phase<EpiMerge, pg8::PairOrder, true, true>(lds, g, S, E);
    }
    xcd_barrier(bar);

#endif
#if (MK_PH >> 5) & 1
    {
        pg8::Gemm g{MIX, WOUT, MIX, WOUT, NTOK, DMODEL, DMODEL}; pg8::StaticOrder S; S.init(NTOK, DMODEL, G, bx);
        EpiRes E{x, out};
        pg8::gemm_phase<EpiRes, pg8::StaticOrder, true, true>(lds, g, S, E);
    }
    xcd_barrier(bar);

#endif
#if (MK_PH >> 6) & 1
    {
        const int gw = vcu * NWAVES + wave, NGW = G * NWAVES;
        for (int m = gw; m < NTOK; m += NGW) rms_row<false>(out + (size_t)m * DMODEL, norm2_g, HN + (size_t)m * DMODEL, lane);
    }
    xcd_barrier(bar);

#endif
#if (MK_PH >> 7) & 1
    {
        pg8::Gemm g{HN, WFF1, HN, WFF1, NTOK, DFF, DMODEL}; pg8::StaticOrder S; S.init(NTOK, DFF, G, bx);
        EpiRelu2 E{U};
        pg8::gemm_phase<EpiRelu2, pg8::StaticOrder, true, true>(lds, g, S, E);
    }
    xcd_barrier(bar);

#endif
#if (MK_PH >> 8) & 1
    {
        pg8::Gemm g{U, WFF2, U, WFF2, NTOK, DMODEL, DFF}; pg8::StaticOrder S; S.init(NTOK, DMODEL, G, bx);
        EpiRes E{out, out};
        pg8::gemm_phase<EpiRes, pg8::StaticOrder, true, true>(lds, g, S, E);
    }
    xcd_barrier(bar);

#endif
#if (MK_PH >> 9) & 1
    {
        const int gw = vcu * NWAVES + wave, NGW = G * NWAVES;
        for (int m = gw; m < NTOK; m += NGW) rms_row<true>(out + (size_t)m * DMODEL, normf_g, out + (size_t)m * DMODEL, lane);
    }
#endif
}

extern "C" void kernel_launch(void* const* d_in, const int* in_sizes, int n_in, void* d_out, int out_size, void* d_ws, size_t ws_size, hipStream_t stream) {
    static int grid = 0;
    if (grid == 0) {
        if (n_in != 16 || in_sizes[0] != NTOK * DMODEL || out_size != NTOK * DMODEL || ws_size < WS_END) {
            fprintf(stderr, "kernel_launch: unexpected shapes (n_in %d, in0 %d, out %d, ws %zu); nothing launched\n", n_in, n_in > 0 ? in_sizes[0] : -1, out_size, ws_size); grid = -1; return; }
        int dev = 0, cus = 0, per_cu = 0;
        if (hipGetDevice(&dev) != hipSuccess || hipDeviceGetAttribute(&cus, hipDeviceAttributeMultiprocessorCount, dev) != hipSuccess) { fprintf(stderr, "kernel_launch: device query failed\n"); grid = -1; return; }
        if (hipFuncSetAttribute((const void*)mega_fwd, hipFuncAttributeMaxDynamicSharedMemorySize, LDS_BYTES) != hipSuccess) { fprintf(stderr, "kernel_launch: hipFuncSetAttribute failed\n"); grid = -1; return; }
        if (hipOccupancyMaxActiveBlocksPerMultiprocessor(&per_cu, (const void*)mega_fwd, NWAVES * 64, LDS_BYTES) != hipSuccess || per_cu < 1)
            fprintf(stderr, "kernel_launch: note: occupancy query reports %d workgroups per CU\n", per_cu);
        (void)hipGetLastError();
        grid = cus;
    }
    if (grid < 0) return;
    if (hipMemsetAsync((char*)d_ws + WS_CTL, 0, CTL_ZERO_BYTES, stream) != hipSuccess) { fprintf(stderr, "kernel_launch: hipMemsetAsync failed\n"); return; }
    Args a{};
    for (int i = 0; i < 16; ++i) a.in[i] = (const float*)d_in[i];
    a.out = (float*)d_out; a.ws = (unsigned char*)d_ws;
    hipLaunchKernelGGL(mega_fwd, dim3(grid), dim3(NWAVES * 64), LDS_BYTES, stream, a);
    const hipError_t le = hipPeekAtLastError();
    if (le != hipSuccess) fprintf(stderr, "kernel_launch: launch failed: %s\n", hipGetErrorName(le));
}
```

```cpp
#include <hip/hip_runtime.h>
#include <cstdio>
#include <cstdint>
#include <cmath>
#ifndef MK_LAUNDER_GEMM
#define MK_LAUNDER_GEMM 1
#endif
#ifndef MK_KPHASE
#define MK_KPHASE 0
#endif
namespace pg8 {
#define PG8_LAS __attribute__((address_space(3)))
typedef unsigned short bf16_t;
typedef short bf16x8 __attribute__((ext_vector_type(8)));
typedef float f32x4 __attribute__((ext_vector_type(4)));
typedef unsigned u32x4 __attribute__((ext_vector_type(4)));
constexpr int BM = 256, BK = 64, HALF = 128, HTB = HALF * BK * 2  , STAGE_BYTES = 8 * HTB, NXCD = 8, WGM = 8;

__host__ __device__ __forceinline__ int lds_byte(int r, int c) { const int st = (r >> 4) * 2 + (c >> 5), rr = r & 15, cc = c & 31, ob = rr * 64 + cc * 2; return st * 1024 + (ob ^ (((ob >> 9) & 1) << 5)); }
__host__ __device__ __forceinline__ void stage_rc(int b, int& R, int& C) { const int st = b / 1024, sb = b % 1024, swz = sb ^ (((sb >> 9) & 1) << 5); R = (st >> 1) * 16 + swz / 64; C = (st & 1) * 32 + (swz % 64) / 2; }
__host__ __device__ __forceinline__ int perm32(int rho) { const int n = rho >> 4, i = rho & 15; return 8 * (i >> 2) + 4 * n + (i & 3); }

struct Unit { int pm, pn, src; };
struct Gemm { const bf16_t* A; const bf16_t* Bt; const bf16_t* A2; const bf16_t* Bt2; int M, N, K; };
struct StaticOrder {
    int nM, nN, nwg, G, c;
    __host__ __device__ void init(int M, int N, int G_, int c_) { nM = M / BM; nN = N / BM; nwg = nM * nN; G = G_; c = c_; }
    __host__ __device__ bool tile(long L, Unit& u) const {
        if (L >= nwg) return false;
        int wgid = (int)L; { const int q = nwg / NXCD, r = nwg % NXCD, xcd = wgid % NXCD, off = wgid / NXCD; wgid = (xcd < r ? xcd * (q + 1) : r * (q + 1) + (xcd - r) * q) + off; }
        const int nig = WGM * nN, gid = wgid / nig, fm = gid * WGM, gsz = (nM - fm) < WGM ? (nM - fm) : WGM;
        u.pm = fm + ((wgid % nig) % gsz); u.pn = (wgid % nig) / gsz; return true;
    }
    __host__ __device__ bool next(int i, Unit& u) const { u.src = 0; return tile((long)i * G + c, u); }
    __device__ __forceinline__ void a_ready(const Unit&) const {}
    __device__ __forceinline__ void done(const Unit&) const {}
};
struct PairOrder : StaticOrder {
    __host__ __device__ bool next(int i, Unit& u) const { u.src = i & 1; return tile((long)(i >> 1) * G + c, u); }
};
__device__ __forceinline__ unsigned cvt_pk_bf16(float lo, float hi) { unsigned r; asm volatile("v_cvt_pk_bf16_f32 %0, %1, %2" : "=v"(r) : "v"(lo), "v"(hi)); return r; }
template <class Epi, class Sched, bool ALIGN_EPI = false, bool SP2 = false>
__device__ __forceinline__ void gemm_phase(PG8_LAS unsigned char* lds, const Gemm g, const Sched& S, const Epi& E) {
    int tid_ = threadIdx.x;
#if MK_LAUNDER_GEMM
    asm volatile("" : "+v"(tid_));
#endif
    const int tid = tid_, wid = __builtin_amdgcn_readfirstlane(tid >> 6), lane = tid & 63, wr = wid >> 2, wc = wid & 3, fr = lane & 15, fq = lane >> 4;
    const int K = g.K, nt = K / BK;
    unsigned voffA[2], voffB[2];
#pragma unroll
    for (int i = 0; i < 2; ++i) { int R, C; stage_rc(tid * 16 + i * 8192, R, C); const int Rb = Epi::PERM ? ((R & ~31) + perm32(R & 31)) : R;
        voffA[i] = (unsigned)(R * K + C) * 2u; voffB[i] = (unsigned)(Rb * K + C) * 2u; }
    const size_t kstep = (size_t)(BK * 2);
    const size_t hstep = (size_t)HALF * K * 2;
    const size_t tstep = 2 * hstep;
    const unsigned ldsw = (unsigned)wid * 1024u;
    const int aoff = lds_byte(wr * 64 + fr, fq * 8), boff = lds_byte(wc * 32 + fr, fq * 8);
#define PG8_SA(b, h) (((b) * 2 + (h)) * HTB)
#define PG8_SB(b, h) ((4 + (b) * 2 + (h)) * HTB)
#define PG8_STAGE(bufoff, gbase, voff) do { _Pragma("unroll") for (int _i = 0; _i < 2; ++_i) \
        __builtin_amdgcn_global_load_lds((const unsigned*)((const char*)(gbase) + (voff)[_i]), (PG8_LAS unsigned*)(lds + (bufoff) + ldsw + _i * 8192), 16, 0, 0); } while (0)
#define PG8_LDA(dst, b, h) do { _Pragma("unroll") for (int m = 0; m < 4; ++m) _Pragma("unroll") for (int k = 0; k < 2; ++k) dst[m][k] = *(const PG8_LAS bf16x8*)(lds + PG8_SA(b, h) + aoff + m * 2048 + k * 1024); } while (0)
#define PG8_LDB(dst, b, h) do { _Pragma("unroll") for (int n = 0; n < 2; ++n) _Pragma("unroll") for (int k = 0; k < 2; ++k) dst[n][k] = *(const PG8_LAS bf16x8*)(lds + PG8_SB(b, h) + boff + n * 2048 + k * 1024); } while (0)
#define PG8_MMA(ai, bj, At, Bt) do { __builtin_amdgcn_s_setprio(1); _Pragma("unroll") for (int m = 0; m < 4; ++m) _Pragma("unroll") for (int n = 0; n < 2; ++n) _Pragma("unroll") for (int k = 0; k < 2; ++k) \
        acc[ai][bj][m][n] = __builtin_amdgcn_mfma_f32_16x16x32_bf16(Bt[n][k], At[m][k], acc[ai][bj][m][n], 0, 0, 0); __builtin_amdgcn_s_setprio(0); } while (0)
#define PG8_WAIT_V(n) asm volatile("s_waitcnt vmcnt(" #n ")" ::: "memory")
#define PG8_WAIT_L(n) asm volatile("s_waitcnt lgkmcnt(" #n ")" ::: "memory")
#define PG8_BAR __builtin_amdgcn_s_barrier()
#define PG8_SCHED __builtin_amdgcn_sched_barrier(0)
    Unit cur, nxt; int ui = 0;
    if (!S.next(0, cur)) return;
    f32x4 acc[2][2][4][2];
#pragma unroll
    for (int a = 0; a < 2; ++a)
#pragma unroll
        for (int b = 0; b < 2; ++b)
#pragma unroll
            for (int m = 0; m < 4; ++m)
#pragma unroll
                for (int n = 0; n < 2; ++n) acc[a][b][m][n] = (f32x4){0.f, 0.f, 0.f, 0.f};
    bf16x8 At[4][2], B0[2][2], B1[2][2];
    const char* cA = (const char*)(cur.src ? g.A2 : g.A) + (size_t)cur.pm * tstep; const char* cB = (const char*)(cur.src ? g.Bt2 : g.Bt) + (size_t)cur.pn * tstep;
    S.a_ready(cur);
    if constexpr (SP2) {
        PG8_STAGE(PG8_SB(0, 0), cB, voffB); PG8_STAGE(PG8_SB(0, 1), cB + hstep, voffB); PG8_STAGE(PG8_SA(0, 0), cA, voffA); PG8_STAGE(PG8_SA(0, 1), cA + hstep, voffA);
        if (wr == 1) PG8_BAR;
        PG8_WAIT_V(2); PG8_BAR;
        PG8_STAGE(PG8_SB(1, 0), cB + kstep, voffB); PG8_STAGE(PG8_SA(1, 0), cA + kstep, voffA); PG8_STAGE(PG8_SB(1, 1), cB + hstep + kstep, voffB);
        PG8_WAIT_V(6); PG8_BAR;
    } else {
        PG8_STAGE(PG8_SB(0, 0), cB, voffB); PG8_STAGE(PG8_SA(0, 0), cA, voffA); PG8_STAGE(PG8_SB(0, 1), cB + hstep, voffB); PG8_STAGE(PG8_SA(0, 1), cA + hstep, voffA);
        if (wr == 1) PG8_BAR;
        PG8_WAIT_V(4); PG8_BAR;
        PG8_STAGE(PG8_SB(1, 0), cB + kstep, voffB); PG8_STAGE(PG8_SA(1, 0), cA + kstep, voffA); PG8_STAGE(PG8_SB(1, 1), cB + hstep + kstep, voffB);
        PG8_WAIT_V(6); PG8_BAR;
    }
    for (;;) {
        const bool has_next = S.next(ui + 1, nxt);
        const char* nA = has_next ? (const char*)(nxt.src ? g.A2 : g.A) + (size_t)nxt.pm * tstep : cA; const char* nB = has_next ? (const char*)(nxt.src ? g.Bt2 : g.Bt) + (size_t)nxt.pn * tstep : cB;
        for (int t = 0; t < nt; t += 2) {
#if MK_KPHASE == 1
            asm volatile(".p2align 3" ::: "memory");
#elif MK_KPHASE == 2
            asm volatile(".p2align 3\n\ts_nop 0" ::: "memory");
#endif
            const bool last = (t == nt - 2);
            const char* a1 = cA + (size_t)(t + 1) * kstep;
            const char* a2 = last ? nA : cA + (size_t)(t + 2) * kstep; const char* b2 = last ? nB : cB + (size_t)(t + 2) * kstep;
            const char* a3 = a2 + kstep; const char* b3 = b2 + kstep;
            if (last && has_next) S.a_ready(nxt);
            if constexpr (SP2) {
            PG8_LDB(B0, 0, 0); PG8_LDB(B1, 0, 1); PG8_SCHED; PG8_LDA(At, 0, 0); PG8_STAGE(PG8_SA(1, 1), a1 + hstep, voffA);
            PG8_WAIT_V(8); PG8_WAIT_L(0); PG8_BAR; PG8_MMA(0, 0, At, B0); PG8_MMA(0, 1, At, B1); PG8_BAR; PG8_SCHED;
            PG8_LDA(At, 0, 1); PG8_STAGE(PG8_SB(0, 0), b2, voffB); PG8_STAGE(PG8_SB(0, 1), b2 + hstep, voffB); PG8_STAGE(PG8_SA(0, 0), a2, voffA);
            PG8_WAIT_V(8); PG8_WAIT_L(0); PG8_BAR; PG8_MMA(1, 0, At, B0); PG8_MMA(1, 1, At, B1); PG8_BAR; PG8_SCHED;
            PG8_LDB(B0, 1, 0); PG8_LDB(B1, 1, 1); PG8_SCHED; PG8_LDA(At, 1, 0); PG8_STAGE(PG8_SA(0, 1), a2 + hstep, voffA);
            PG8_WAIT_V(8); PG8_WAIT_L(0); PG8_BAR; PG8_MMA(0, 0, At, B0); PG8_MMA(0, 1, At, B1); PG8_BAR; PG8_SCHED;
            PG8_LDA(At, 1, 1); PG8_STAGE(PG8_SB(1, 0), b3, voffB); PG8_STAGE(PG8_SB(1, 1), b3 + hstep, voffB); PG8_STAGE(PG8_SA(1, 0), a3, voffA);
            PG8_WAIT_V(8); PG8_WAIT_L(0); PG8_BAR; PG8_MMA(1, 0, At, B0); PG8_MMA(1, 1, At, B1); PG8_BAR; PG8_SCHED;
            } else {
            PG8_LDB(B0, 0, 0); PG8_SCHED; PG8_LDA(At, 0, 0); PG8_STAGE(PG8_SA(1, 1), a1 + hstep, voffA);
            PG8_WAIT_L(8); PG8_BAR; PG8_WAIT_L(0); PG8_MMA(0, 0, At, B0); PG8_BAR; PG8_SCHED;
            PG8_LDB(B1, 0, 1); PG8_STAGE(PG8_SB(0, 0), b2, voffB);
            PG8_BAR; PG8_WAIT_L(0); PG8_MMA(0, 1, At, B1); PG8_BAR;
            PG8_LDA(At, 0, 1); PG8_STAGE(PG8_SA(0, 0), a2, voffA);
            PG8_BAR; PG8_WAIT_L(0); PG8_MMA(1, 0, At, B0); PG8_BAR; PG8_SCHED;
            PG8_STAGE(PG8_SB(0, 1), b2 + hstep, voffB);
            PG8_WAIT_V(6); PG8_BAR; PG8_MMA(1, 1, At, B1); PG8_BAR;
            PG8_LDB(B0, 1, 0); PG8_SCHED; PG8_LDA(At, 1, 0); PG8_STAGE(PG8_SA(0, 1), a2 + hstep, voffA);
            PG8_WAIT_L(8); PG8_BAR; PG8_WAIT_L(0); PG8_MMA(0, 0, At, B0); PG8_BAR; PG8_SCHED;
            PG8_LDB(B1, 1, 1); PG8_STAGE(PG8_SB(1, 0), b3, voffB);
            PG8_BAR; PG8_WAIT_L(0); PG8_MMA(0, 1, At, B1); PG8_BAR;
            PG8_LDA(At, 1, 1); PG8_STAGE(PG8_SA(1, 0), a3, voffA);
            PG8_BAR; PG8_WAIT_L(0); PG8_MMA(1, 0, At, B0); PG8_BAR; PG8_SCHED;
            PG8_STAGE(PG8_SB(1, 1), b3 + hstep, voffB);
            PG8_WAIT_V(6); PG8_BAR; PG8_MMA(1, 1, At, B1); PG8_BAR;
            }
        }
        if constexpr (ALIGN_EPI) { if (wr == 0) PG8_BAR; }
        if constexpr (!Epi::AFTER_DRAIN) { E(acc, cur, wr, wc, fr, fq); S.done(cur); }
        if (!has_next) break;
#pragma unroll
        for (int a = 0; a < 2; ++a)
#pragma unroll
            for (int b = 0; b < 2; ++b)
#pragma unroll
                for (int m = 0; m < 4; ++m)
#pragma unroll
                    for (int n = 0; n < 2; ++n) acc[a][b][m][n] = (f32x4){0.f, 0.f, 0.f, 0.f};
        cur = nxt; cA = nA; cB = nB; ++ui;
        if constexpr (ALIGN_EPI) { if (wr == 1) PG8_BAR; }
    }
    PG8_WAIT_V(0);
    if constexpr (!ALIGN_EPI) { if (wr == 0) PG8_BAR; }
    PG8_BAR;
    if constexpr (Epi::AFTER_DRAIN) { E.fused(acc, cur, wr, wc, fr, fq, lds, wid, lane); S.done(cur); }
#undef PG8_SA
#undef PG8_SB
#undef PG8_STAGE
#undef PG8_LDA
#undef PG8_LDB
#undef PG8_MMA
#undef PG8_WAIT_V
#undef PG8_WAIT_L
#undef PG8_BAR
#undef PG8_SCHED
}
}
#define GAS __attribute__((address_space(1)))
#define LAS __attribute__((address_space(3)))
typedef unsigned short bf16;
typedef unsigned v4u __attribute__((ext_vector_type(4)));
typedef float f32x4 __attribute__((ext_vector_type(4)));
typedef short bf16x8 __attribute__((ext_vector_type(8)));
typedef GAS unsigned gu32;
typedef GAS unsigned long long gu64;
#define RLX_AGENT __ATOMIC_RELAXED, __HIP_MEMORY_SCOPE_AGENT
#define LDS_WAIT() asm volatile("s_waitcnt lgkmcnt(0)" ::: "memory")
#define VM_WAIT() asm volatile("s_waitcnt vmcnt(0)" ::: "memory")
__device__ __forceinline__ unsigned long long rt() { return __builtin_amdgcn_s_memrealtime(); }
__device__ __forceinline__ unsigned f2bf(float f) { unsigned u = __builtin_bit_cast(unsigned, f); return (u + 0x7fffu + ((u >> 16) & 1u)) >> 16; }
__device__ __forceinline__ unsigned pk2(float lo, float hi) { return f2bf(lo) | (f2bf(hi) << 16); }

#define XB_TMO      128
#define XB_XCNT(j)  (256  + 64 * (j))
#define XB_XSUB(j)  (1280 + 64 * (j))
#define XB_XGEN(j)  (2304 + 64 * (j))
#define XB_TOP      3328
#define XB_TOPGEN   3392
#define XCD_BAR_WORDS 3456
#define XB_SPIN_CAP (1u << 18)

__device__ __forceinline__ unsigned xb_ld(unsigned* p)              { return __hip_atomic_load(p, __ATOMIC_RELAXED, __HIP_MEMORY_SCOPE_AGENT); }
__device__ __forceinline__ unsigned xb_add(unsigned* p, unsigned v) { return __hip_atomic_fetch_add(p, v, __ATOMIC_RELAXED, __HIP_MEMORY_SCOPE_AGENT); }
__device__ __forceinline__ unsigned xb_xcc_id() { return (unsigned)__builtin_amdgcn_s_getreg((3 << 11) | 20) & 0xFu; }
#define XB_SPIN(cond, bar) do { unsigned _sp = 0; while (cond) { __builtin_amdgcn_s_sleep(1); \
    if ((++_sp & 255u) == 0u) { if (xb_ld(&(bar)[XB_TMO])) break; if (_sp > XB_SPIN_CAP) { atomicAdd(&(bar)[XB_TMO], 1u); break; } } } } while (0)

struct XcdBarrier {
    unsigned* bar; unsigned x;
    volatile LAS unsigned* st;
};

__device__ __forceinline__ XcdBarrier xcd_barrier_post(unsigned* bar, volatile LAS unsigned* st) {
    XcdBarrier b; b.bar = bar; b.x = xb_xcc_id(); b.st = st;
    if (threadIdx.x == 0) (void)xb_add(&bar[XB_XCNT(b.x)], 1u);
    return b;
}
__device__ __forceinline__ void xcd_barrier_complete(unsigned* bar, unsigned x, unsigned& nloc, unsigned& nx) {
    const unsigned G = gridDim.x * gridDim.y * gridDim.z;
    unsigned sum, cnt, mine, sp = 0u;
    for (;;) {
        sum = 0u; cnt = 0u; mine = 0u;
#pragma unroll
        for (unsigned j = 0; j < 16; ++j) { const unsigned c = xb_ld(&bar[XB_XCNT(j)]); sum += c; cnt += (c > 0u) ? 1u : 0u; mine = (j == x) ? c : mine; }
        if (sum == G) break;
        __builtin_amdgcn_s_sleep(1);
        if ((++sp & 255u) == 0u) { if (xb_ld(&bar[XB_TMO])) break; if (sp > XB_SPIN_CAP) { atomicAdd(&bar[XB_TMO], 1u); break; } }
    }
    nloc = mine > 0u ? mine : 1u; nx = cnt > 0u ? cnt : 1u;
}

__device__ __forceinline__ void xcd_barrier(const XcdBarrier& b) {
    asm volatile("s_waitcnt vmcnt(0)" ::: "memory");
    __syncthreads();
    if (threadIdx.x == 0) {
        unsigned* bar = b.bar;
        __builtin_amdgcn_s_waitcnt(0);
        unsigned nloc = b.st[0], nx = b.st[1];
        if (nloc == 0u) { xcd_barrier_complete(bar, b.x, nloc, nx); b.st[0] = nloc; b.st[1] = nx; }
        const unsigned old = xb_add(&bar[XB_XSUB(b.x)], 1u);
        const unsigned gen = old / nloc;
        if (old + 1u == (gen + 1u) * nloc) {
            __builtin_amdgcn_fence(__ATOMIC_RELEASE, "agent");
            asm volatile("s_waitcnt vmcnt(0)" ::: "memory");
            const unsigned og = xb_add(&bar[XB_TOP], 1u);
            const unsigned tg = og / nx;
            if (og + 1u == (tg + 1u) * nx) xb_add(&bar[XB_TOPGEN], 1u);
            else XB_SPIN(xb_ld(&bar[XB_TOPGEN]) == tg, bar);
            __builtin_amdgcn_fence(__ATOMIC_ACQUIRE, "agent");
            xb_add(&bar[XB_XGEN(b.x)], 1u);
            asm volatile("s_waitcnt vmcnt(0)" ::: "memory");
        } else {
            XB_SPIN(xb_ld(&bar[XB_XGEN(b.x)]) == gen, bar);
            __builtin_amdgcn_fence(__ATOMIC_ACQUIRE, "agent");
            asm volatile("s_waitcnt vmcnt(0)" ::: "memory");
        }
    }
    __syncthreads();
}

typedef float f32x16 __attribute__((ext_vector_type(16)));
typedef short s16x4 __attribute__((ext_vector_type(4)));
typedef short v4i16_t __attribute__((ext_vector_type(4)));
typedef unsigned u32x2 __attribute__((ext_vector_type(2)));
typedef float f32x2_t __attribute__((ext_vector_type(2)));
typedef __bf16 bf16x2_t __attribute__((ext_vector_type(2)));

constexpr int NTOK = 32768, SEQ = 4096, DMODEL = 1024, DFF = 4096;
constexpr int LDP = 4864;
constexpr int NPROJ = 5120;
constexpr int INW = 4888;
constexpr float NORM_EPS = 1e-6f;
constexpr size_t MiB = 1u << 20;
constexpr size_t WS_CTL = 0, CTL_ZERO_BYTES = 1 * MiB;
constexpr size_t WS_WIN = 2 * MiB, WS_WUPN = 12 * MiB, WS_WUPM = 13 * MiB, WS_WOUT = 14 * MiB, WS_WFF1 = 16 * MiB, WS_WFF2 = 24 * MiB;
constexpr size_t WS_WC1K = 32 * MiB, WS_WC1V = 32 * MiB + 256 * 1024, WS_ROPE = 32 * MiB + 512 * 1024;
constexpr size_t WS_KC = 33 * MiB, WS_VC = 33 * MiB + 512 * 1024, WS_KMH = 34 * MiB, WS_KML = 34 * MiB + 256 * 1024;
constexpr size_t WS_SSQ = 460 * MiB;
constexpr size_t WS_GN = 35 * MiB;
constexpr size_t WS_QR = 40 * MiB;
constexpr size_t WS_HN = 72 * MiB;
constexpr size_t WS_YN = 72 * MiB, WS_YM = 104 * MiB;
constexpr size_t WS_MIX = 136 * MiB;
constexpr size_t WS_P = 200 * MiB;
constexpr size_t WS_U = 200 * MiB;
constexpr size_t WS_END = 504 * MiB;
constexpr int CW_BAR = 4096;

constexpr int LDS_BYTES = 147456, MISC_OFF = LDS_BYTES - 2048;
constexpr int NWAVES = 8;

__device__ __forceinline__ float bflo(unsigned w) { return __uint_as_float(w << 16); }
__device__ __forceinline__ float bfhi(unsigned w) { return __uint_as_float(w & 0xffff0000u); }
__device__ __forceinline__ unsigned cvtpk_s(float lo, float hi) { f32x2_t v = {lo, hi}; bf16x2_t b = __builtin_convertvector(v, bf16x2_t); return __builtin_bit_cast(unsigned, b); }
__device__ __forceinline__ float wave_sum(float v) {
#pragma unroll
    for (int o = 1; o < 64; o <<= 1) v += __shfl_xor(v, o);
    return v;
}
constexpr float QSCALE = 0.125f * 1.4426950408889634f;
__device__ __forceinline__ float sigmoidf_(float v) { return 1.0f / (1.0f + __expf(-v)); }

struct EpiProj {
    static constexpr bool PERM = true, AFTER_DRAIN = false;
    bf16* P; bf16* QR; float* GN; const float* rope;
    __device__ __forceinline__ void operator()(const f32x4 (&acc)[2][2][4][2], const pg8::Unit& u, int wr, int wc, int fr, int fq) const {
        const int pn = u.pn; const int row0 = u.pm * 256 + wr * 64 + fr;
        const bool ropelane = ((wc & 1) == 0) && (fq < 2);
#pragma unroll
        for (int bj = 0; bj < 2; ++bj) {
            int mode;
            if (pn < 2) mode = 2; else if (pn == 2) mode = 0; else if (pn <= 4) mode = (bj == 0) ? 1 : 0; else if (pn <= 8) mode = 1; else if (pn <= 10) mode = 0; else if (pn <= 18) mode = 3; else mode = 4;
            const int col = pn * 256 + bj * 128 + wc * 32 + 8 * fq;
#pragma unroll
            for (int ai = 0; ai < 2; ++ai)
#pragma unroll
                for (int m = 0; m < 4; ++m) {
                    const int row = row0 + ai * 128 + m * 16;
                    const f32x4 a0 = acc[ai][bj][m][0], a1 = acc[ai][bj][m][1];
                    float v[8] = {a0[0], a0[1], a0[2], a0[3], a1[0], a1[1], a1[2], a1[3]};
                    if (mode == 1 || mode == 2) {
                        float pv[8], o[8];
#pragma unroll
                        for (int i = 0; i < 8; ++i) { pv[i] = __shfl_xor(v[i], 16); o[i] = v[i]; }
                        if (ropelane) {
                            const float* cs = rope + (size_t)(row & (SEQ - 1)) * 16;
                            const f32x4 c0 = *(const f32x4*)cs, c1 = *(const f32x4*)(cs + 4), s0 = *(const f32x4*)(cs + 8), s1 = *(const f32x4*)(cs + 12);
                            const float c[8] = {c0[0], c0[1], c0[2], c0[3], c1[0], c1[1], c1[2], c1[3]}, s[8] = {s0[0], s0[1], s0[2], s0[3], s1[0], s1[1], s1[2], s1[3]};
#pragma unroll
                            for (int i = 0; i < 8; ++i) o[i] = (fq == 0) ? (v[i] * c[i] - pv[i] * s[i]) : (pv[i] * s[i] + v[i] * c[i]);
                        }
                        if (mode == 2 || pn == 5 || pn == 6) {
#pragma unroll
                            for (int i = 0; i < 8; ++i) o[i] *= QSCALE;
                        }
                        if (mode == 2) {
                            v4u w; w.x = cvtpk_s(v[0], v[1]); w.y = cvtpk_s(v[2], v[3]); w.z = cvtpk_s(v[4], v[5]); w.w = cvtpk_s(v[6], v[7]);
                            *(v4u*)(P + (size_t)row * LDP + col) = w;
                            v4u w2; w2.x = cvtpk_s(o[0], o[1]); w2.y = cvtpk_s(o[2], o[3]); w2.z = cvtpk_s(o[4], o[5]); w2.w = cvtpk_s(o[6], o[7]);
                            *(v4u*)(QR + (size_t)row * 512 + col) = w2;
                        } else {
                            v4u w2; w2.x = cvtpk_s(o[0], o[1]); w2.y = cvtpk_s(o[2], o[3]); w2.z = cvtpk_s(o[4], o[5]); w2.w = cvtpk_s(o[6], o[7]);
                            *(v4u*)(P + (size_t)row * LDP + col) = w2;
                        }
                    } else if (mode == 0) {
                        v4u w; w.x = cvtpk_s(v[0], v[1]); w.y = cvtpk_s(v[2], v[3]); w.z = cvtpk_s(v[4], v[5]); w.w = cvtpk_s(v[6], v[7]);
                        *(v4u*)(P + (size_t)row * LDP + col) = w;
                    } else if (mode == 3) {
#pragma unroll
                        for (int i = 0; i < 8; ++i) v[i] = sigmoidf_(v[i]);
                        v4u w; w.x = cvtpk_s(v[0], v[1]); w.y = cvtpk_s(v[2], v[3]); w.z = cvtpk_s(v[4], v[5]); w.w = cvtpk_s(v[6], v[7]);
                        *(v4u*)(P + (size_t)row * LDP + col) = w;
                    } else {
                        if (bj == 0 && wc == 0 && fq < 3) {
                            float* gp = GN + (size_t)row * 32 + 8 * fq;
                            *(f32x4*)gp = (f32x4){sigmoidf_(v[0]), sigmoidf_(v[1]), sigmoidf_(v[2]), sigmoidf_(v[3])};
                            *(f32x4*)(gp + 4) = (f32x4){sigmoidf_(v[4]), sigmoidf_(v[5]), sigmoidf_(v[6]), sigmoidf_(v[7])};
                        }
                    }
                }
        }
    }
};
struct EpiMerge {
    static constexpr bool PERM = true, AFTER_DRAIN = false;
    const bf16* P; bf16* MIX;
    __device__ __forceinline__ void operator()(const f32x4 (&acc)[2][2][4][2], const pg8::Unit& u, int wr, int wc, int fr, int fq) const {
        const int row0 = u.pm * 256 + wr * 64 + fr; const int src = u.src;
#pragma unroll
        for (int ai = 0; ai < 2; ++ai)
#pragma unroll
            for (int m = 0; m < 4; ++m) {
                const int row = row0 + ai * 128 + m * 16;
#pragma unroll
                for (int bj = 0; bj < 2; ++bj) {
                    const int col = u.pn * 256 + bj * 128 + wc * 32 + 8 * fq;
                    const v4u gw = *(const v4u*)(P + (size_t)row * LDP + 2816 + src * 1024 + col);
                    const f32x4 a0 = acc[ai][bj][m][0], a1 = acc[ai][bj][m][1];
                    float r[8] = {a0[0] * bflo(gw.x), a0[1] * bfhi(gw.x), a0[2] * bflo(gw.y), a0[3] * bfhi(gw.y), a1[0] * bflo(gw.z), a1[1] * bfhi(gw.z), a1[2] * bflo(gw.w), a1[3] * bfhi(gw.w)};
                    bf16* mp = MIX + (size_t)row * DMODEL + col;
                    if (src) { const v4u pw = *(const v4u*)mp;
                        r[0] += bflo(pw.x); r[1] += bfhi(pw.x); r[2] += bflo(pw.y); r[3] += bfhi(pw.y); r[4] += bflo(pw.z); r[5] += bfhi(pw.z); r[6] += bflo(pw.w); r[7] += bfhi(pw.w); }
                    v4u w; w.x = cvtpk_s(r[0], r[1]); w.y = cvtpk_s(r[2], r[3]); w.z = cvtpk_s(r[4], r[5]); w.w = cvtpk_s(r[6], r[7]);
                    *(v4u*)mp = w;
                }
            }
    }
};
struct EpiRes {
    static constexpr bool PERM = false, AFTER_DRAIN = false;
    const float* base; float* out;
    __device__ __forceinline__ void operator()(const f32x4 (&acc)[2][2][4][2], const pg8::Unit& u, int wr, int wc, int fr, int fq) const {
        const int row0 = u.pm * 256 + wr * 64 + fr; const int col0 = u.pn * 256 + wc * 32 + 4 * fq;
#pragma unroll
        for (int ai = 0; ai < 2; ++ai)
#pragma unroll
            for (int m = 0; m < 4; ++m) {
                const size_t off = (size_t)(row0 + ai * 128 + m * 16) * DMODEL + col0;
#pragma unroll
                for (int bj = 0; bj < 2; ++bj)
#pragma unroll
                    for (int n = 0; n < 2; ++n) { const f32x4 bs = *(const f32x4*)(base + off + bj * 128 + n * 16); *(f32x4*)(out + off + bj * 128 + n * 16) = bs + acc[ai][bj][m][n]; }
            }
    }
};
struct EpiResNorm {
    static constexpr bool PERM = false, AFTER_DRAIN = false;
    const float* base; float* out; bf16* XB; const float* g; float* SSQ;
    __device__ __forceinline__ void operator()(const f32x4 (&acc)[2][2][4][2], const pg8::Unit& u, int wr, int wc, int fr, int fq) const {
        const int row0 = u.pm * 256 + wr * 64 + fr; const int col0 = u.pn * 256 + wc * 32 + 4 * fq;
        f32x4 gv[2][2];
#pragma unroll
        for (int bj = 0; bj < 2; ++bj)
#pragma unroll
            for (int n = 0; n < 2; ++n) gv[bj][n] = *(const f32x4*)(g + col0 + bj * 128 + n * 16);
#pragma unroll
        for (int ai = 0; ai < 2; ++ai)
#pragma unroll
            for (int m = 0; m < 4; ++m) {
                const int row = row0 + ai * 128 + m * 16; const size_t off = (size_t)row * DMODEL + col0; float ss = 0.f;
#pragma unroll
                for (int bj = 0; bj < 2; ++bj)
#pragma unroll
                    for (int n = 0; n < 2; ++n) { const f32x4 v = *(const f32x4*)(base + off + bj * 128 + n * 16) + acc[ai][bj][m][n]; *(f32x4*)(out + off + bj * 128 + n * 16) = v;
                        ss += (v.x * v.x + v.y * v.y) + (v.z * v.z + v.w * v.w);
                        const f32x4 h = v * gv[bj][n]; *(u32x2*)(XB + off + bj * 128 + n * 16) = (u32x2){cvtpk_s(h.x, h.y), cvtpk_s(h.z, h.w)}; }
                ss += __shfl_xor(ss, 16); ss += __shfl_xor(ss, 32);
                if (fq == 0) SSQ[(size_t)row * 16 + u.pn * 4 + wc] = ss;
            }
    }
};
struct EpiRelu2 {
    static constexpr bool PERM = true, AFTER_DRAIN = false;
    bf16* U; const float* SSQ;
    __device__ __forceinline__ void operator()(const f32x4 (&acc)[2][2][4][2], const pg8::Unit& u, int wr, int wc, int fr, int fq) const {
        const int row0 = u.pm * 256 + wr * 64 + fr; const int col0 = u.pn * 256 + wc * 32 + 8 * fq;
#pragma unroll
        for (int ai = 0; ai < 2; ++ai)
#pragma unroll
            for (int m = 0; m < 4; ++m) {
                bf16* rp = U + (size_t)(row0 + ai * 128 + m * 16) * DFF + col0;
                const float* sp = SSQ + (size_t)(row0 + ai * 128 + m * 16) * 16;
                const f32x4 s0 = *(const f32x4*)sp, s1 = *(const f32x4*)(sp + 4), s2 = *(const f32x4*)(sp + 8), s3 = *(const f32x4*)(sp + 12);
                const float sst = ((((s0.x + s0.y) + (s0.z + s0.w)) + ((s1.x + s1.y) + (s1.z + s1.w))) + (((s2.x + s2.y) + (s2.z + s2.w)) + ((s3.x + s3.y) + (s3.z + s3.w))));
                const float r2 = 1.0f / (sst * (1.0f / DMODEL) + NORM_EPS);
#pragma unroll
                for (int bj = 0; bj < 2; ++bj) {
                    f32x4 a0 = acc[ai][bj][m][0], a1 = acc[ai][bj][m][1];
#pragma unroll
                    for (int i = 0; i < 4; ++i) { const float x = fmaxf(a0[i], 0.f), y = fmaxf(a1[i], 0.f); a0[i] = x * x * r2; a1[i] = y * y * r2; }
                    v4u w; w.x = cvtpk_s(a0[0], a0[1]); w.y = cvtpk_s(a0[2], a0[3]); w.z = cvtpk_s(a1[0], a1[1]); w.w = cvtpk_s(a1[2], a1[3]);
                    *(v4u*)(rp + bj * 128) = w;
                }
            }
    }
};

__device__ __forceinline__ int win_src_col(int n) { return n < 1280 ? n : (n < 4864 ? n + 24 : (n < INW ? n - 3584 : -1)); }
__device__ __forceinline__ void transpose_item(const float* W, int K, int N, int Nd, bf16* WT, LAS float* scr, int item, int lane, bool remap) {
    const int nblk = Nd / 32, kb = item / nblk, nb = item % nblk, k0 = 64 * kb, n0 = 32 * nb;
    int sc = n0 + (lane & 31); if (remap) sc = win_src_col(sc);
#pragma unroll 8
    for (int i = 0; i < 32; ++i) { const int kk = 2 * i + (lane >> 5); scr[kk * 33 + (lane & 31)] = sc >= 0 ? W[(size_t)(k0 + kk) * N + sc] : 0.f; }
    LDS_WAIT(); asm volatile("" ::: "memory");
    const int c = lane & 7;
#pragma unroll
    for (int j = 0; j < 4; ++j) { const int n = (lane >> 3) + 8 * j; const LAS float* s = scr + (8 * c) * 33 + n;
        v4u o; o.x = pk2(s[0 * 33], s[1 * 33]); o.y = pk2(s[2 * 33], s[3 * 33]); o.z = pk2(s[4 * 33], s[5 * 33]); o.w = pk2(s[6 * 33], s[7 * 33]);
        *(GAS v4u*)(WT + (size_t)(n0 + n) * K + k0 + 8 * c) = o; }
    LDS_WAIT(); asm volatile("" ::: "memory");
}
template <bool OUTF32> __device__ __forceinline__ void rms_row(const float* xrow, const float* g, void* orow, int lane) {
    const f32x4* xr = (const f32x4*)xrow + lane; const f32x4* gr = (const f32x4*)g + lane;
    f32x4 v[4]; float s = 0.f;
#pragma unroll
    for (int j = 0; j < 4; ++j) { v[j] = xr[64 * j]; s += (v[j].x * v[j].x + v[j].y * v[j].y) + (v[j].z * v[j].z + v[j].w * v[j].w); }
    const float rstd = 1.0f / sqrtf(wave_sum(s) * (1.0f / DMODEL) + NORM_EPS);
#pragma unroll
    for (int j = 0; j < 4; ++j) { const f32x4 gg = gr[64 * j]; const f32x4 o = v[j] * rstd * gg;
        if (OUTF32) ((f32x4*)orow + lane)[64 * j] = o;
        else ((u32x2*)orow + lane)[64 * j] = (u32x2){cvtpk_s(o.x, o.y), cvtpk_s(o.z, o.w)}; }
}

namespace att {
constexpr float C2 = 0.125f * 1.4426950408889634f;
__device__ __forceinline__ int crow(int r, int hi) { return (r & 3) + 8 * (r >> 2) + 4 * hi; }
__device__ __forceinline__ float pmax(float v) { auto rr = __builtin_amdgcn_permlane32_swap(__float_as_uint(v), __float_as_uint(v), false, false); return fmaxf(__uint_as_float(rr[0]), __uint_as_float(rr[1])); }
__device__ __forceinline__ float pget(float v, int hi) { auto rr = __builtin_amdgcn_permlane32_swap(__float_as_uint(v), __float_as_uint(v), false, false); return __uint_as_float(hi ? rr[0] : rr[1]); }
__device__ __forceinline__ float psum(float v) { auto rr = __builtin_amdgcn_permlane32_swap(__float_as_uint(v), __float_as_uint(v), false, false); return __uint_as_float(rr[0]) + __uint_as_float(rr[1]); }
__device__ __forceinline__ void stage_kv(LAS unsigned char* lds, int koff, int voff, const bf16* Kt, const bf16* Vt, int pitch, int wid, int lane) {
    const int r = 8 * wid + (lane >> 3), cs = lane & 7;
    const unsigned ko = (unsigned)(r * pitch + ((cs ^ ((r >> 1) & 7)) << 3)), vo = (unsigned)(r * pitch + ((cs ^ (((r >> 1) & 1) << 2)) << 3));
    const bf16* ks = Kt + ko; const bf16* vs = Vt + vo;
    __builtin_amdgcn_global_load_lds((const unsigned*)ks, (LAS unsigned*)(lds + koff + wid * 1024), 16, 0, 0);
    __builtin_amdgcn_global_load_lds((const unsigned*)vs, (LAS unsigned*)(lds + voff + wid * 1024), 16, 0, 0);
}
__device__ __forceinline__ void qkt(f32x16& p0, f32x16& p1, LAS const unsigned char* kslot, const bf16x8 (&q)[4], const f32x16& init, int r32, int hi) {
    LAS const unsigned char* kb = kslot + r32 * 128; const int sw = (r32 >> 1) & 7;
    bf16x8 kf[8];
#pragma unroll
    for (int d0 = 0; d0 < 4; ++d0) { const int x = ((2 * d0 + hi) ^ sw) << 4; kf[2 * d0] = *(LAS const bf16x8*)(kb + x); kf[2 * d0 + 1] = *(LAS const bf16x8*)(kb + x + 4096); }
    __builtin_amdgcn_sched_barrier(0);
    p0 = __builtin_amdgcn_mfma_f32_32x32x16_bf16(kf[0], q[0], init, 0, 0, 0); p1 = __builtin_amdgcn_mfma_f32_32x32x16_bf16(kf[1], q[0], init, 0, 0, 0);
#pragma unroll
    for (int d0 = 1; d0 < 4; ++d0) { p0 = __builtin_amdgcn_mfma_f32_32x32x16_bf16(kf[2 * d0], q[d0], p0, 0, 0, 0); p1 = __builtin_amdgcn_mfma_f32_32x32x16_bf16(kf[2 * d0 + 1], q[d0], p1, 0, 0, 0); }
    __builtin_amdgcn_sched_barrier(0);
}
__device__ __forceinline__ s16x4 vtr(LAS const unsigned char* p) { return __builtin_bit_cast(s16x4, __builtin_amdgcn_ds_read_tr16_b64_v4i16((LAS v4i16_t*)p)); }
__device__ __forceinline__ int vpo_of(int lane) { const int hi = lane >> 5, q = (lane & 15) >> 2, p = lane & 3, dsub = (lane >> 4) & 1; return ((4 * hi + q) * 128 + dsub * 32 + p * 8) | (((q >> 1) & 1) << 30); }
__device__ __forceinline__ void pv(f32x16 (&o)[2], LAS const unsigned char* vslot, int vpo, const bf16x8 (&pa)[4]) {
    const int vsw = ((vpo >> 30) & 1) * 64;
    LAS const unsigned char* vb = vslot + (vpo & 0xffff);
#pragma unroll
    for (int d0 = 0; d0 < 2; ++d0) {
        LAS const unsigned char* vp = vb + (d0 ? 64 - vsw : vsw);
        s16x4 lo[4], h4[4];
#pragma unroll
        for (int i = 0; i < 4; ++i) { lo[i] = vtr(vp + i * 2048); h4[i] = vtr(vp + i * 2048 + 1024); }
        __builtin_amdgcn_sched_barrier(0);
#pragma unroll
        for (int i = 0; i < 4; ++i) {
            const bf16x8 vf = {lo[i][0], lo[i][1], lo[i][2], lo[i][3], h4[i][0], h4[i][1], h4[i][2], h4[i][3]};
            o[d0] = __builtin_amdgcn_mfma_f32_32x32x16_bf16(vf, pa[i], o[d0], 0, 0, 0);
        }
        __builtin_amdgcn_sched_barrier(0);
    }
}
__device__ __forceinline__ void pack_p(bf16x8 (&pa)[4], const f32x16& p0, const f32x16& p1) {
    const v4u w0 = {cvtpk_s(p0[0], p0[1]), cvtpk_s(p0[2], p0[3]), cvtpk_s(p0[4], p0[5]), cvtpk_s(p0[6], p0[7])};
    const v4u w1 = {cvtpk_s(p0[8], p0[9]), cvtpk_s(p0[10], p0[11]), cvtpk_s(p0[12], p0[13]), cvtpk_s(p0[14], p0[15])};
    const v4u w2 = {cvtpk_s(p1[0], p1[1]), cvtpk_s(p1[2], p1[3]), cvtpk_s(p1[4], p1[5]), cvtpk_s(p1[6], p1[7])};
    const v4u w3 = {cvtpk_s(p1[8], p1[9]), cvtpk_s(p1[10], p1[11]), cvtpk_s(p1[12], p1[13]), cvtpk_s(p1[14], p1[15])};
    pa[0] = __builtin_bit_cast(bf16x8, w0); pa[1] = __builtin_bit_cast(bf16x8, w1); pa[2] = __builtin_bit_cast(bf16x8, w2); pa[3] = __builtin_bit_cast(bf16x8, w3);
}
__device__ __forceinline__ void mask_gt(f32x16& p0, f32x16& p1, int lim, int hi) {
#pragma unroll
    for (int r = 0; r < 16; ++r) { const int kk = crow(r, hi); if (kk > lim) p0[r] = -INFINITY; if (kk + 32 > lim) p1[r] = -INFINITY; }
}
__device__ __forceinline__ void mask_le(f32x16& p0, f32x16& p1, int lim, int hi) {
#pragma unroll
    for (int r = 0; r < 16; ++r) { const int kk = crow(r, hi); if (kk <= lim) p0[r] = -INFINITY; if (kk + 32 <= lim) p1[r] = -INFINITY; }
}
__device__ __forceinline__ float tile_max(const f32x16& p0, const f32x16& p1) {
    float rm = fmaxf(p0[0], p1[0]);
#pragma unroll
    for (int r = 1; r < 16; ++r) rm = fmaxf(rm, fmaxf(p0[r], p1[r]));
    return rm;
}
__device__ __forceinline__ float max3f(float a, float b, float c) { float r; asm("v_max3_f32 %0, %1, %2, %3" : "=v"(r) : "v"(a), "v"(b), "v"(c)); return r; }
__device__ __forceinline__ float max2f(float a, float b) { float r; asm("v_max_f32_e32 %0, %1, %2" : "=v"(r) : "v"(a), "v"(b)); return r; }
__device__ __forceinline__ float tile_max3(const f32x16& p0, const f32x16& p1) {
    float a = max3f(p0[0], p0[1], p1[0]), b = max3f(p0[2], p0[3], p1[1]); a = max3f(a, p1[2], p1[3]);
#pragma unroll
    for (int r = 4; r < 16; r += 4) { a = max3f(a, p0[r], p0[r + 1]); b = max3f(b, p0[r + 2], p0[r + 3]); a = max3f(a, p1[r], p1[r + 1]); b = max3f(b, p1[r + 2], p1[r + 3]); }
    return max2f(a, b);
}
__device__ __forceinline__ void fin_add(f32x16 (&y)[2], const f32x16 (&o)[2], float l, float gate) {
    const float lt = psum(l); const float sc = lt > 0.f ? gate / lt : 0.f;
    y[0] += o[0] * sc; y[1] += o[1] * sc;
}
__device__ __forceinline__ void store_y(bf16* yrow, const f32x16 (&y)[2], int hi) {
#pragma unroll
    for (int d0 = 0; d0 < 2; ++d0)
#pragma unroll
        for (int rg = 0; rg < 4; ++rg) {
            const u32x2 w = {cvtpk_s(y[d0][4 * rg], y[d0][4 * rg + 1]), cvtpk_s(y[d0][4 * rg + 2], y[d0][4 * rg + 3])};
            *(u32x2*)(yrow + 32 * d0 + 8 * rg + 4 * hi) = w;
        }
}
__device__ __forceinline__ int next_set(unsigned long long um, int from) { if (from >= 64) return 64; const unsigned long long x = um >> from; return x ? from + __builtin_ctzll(x) : 64; }


constexpr float THR = 8.0f;
#ifndef MK_AHEAD
#define MK_AHEAD 2
#endif
constexpr int AHEAD = MK_AHEAD, NSLOT = (MK_AHEAD == 2) ? 4 : 8;
__device__ __forceinline__ void glds16(const void* gsrc, unsigned lds_dst) { unsigned keep;
    asm volatile("s_mov_b32 %0, m0\n\ts_mov_b32 m0, %2\n\ts_nop 0\n\tglobal_load_lds_dwordx4 %1, off\n\ts_mov_b32 m0, %0" : "=&s"(keep) : "v"(gsrc), "s"(lds_dst) : "memory"); }
__device__ __forceinline__ void stage_kv_asm(unsigned ring_addr, int koff, int voff, const bf16* Kt, const bf16* Vt, int pitch, int wid, int lane) {
    const int r = 8 * wid + (lane >> 3), cs = lane & 7;
    const unsigned ko = (unsigned)(r * pitch + ((cs ^ ((r >> 1) & 7)) << 3)), vo = (unsigned)(r * pitch + ((cs ^ (((r >> 1) & 1) << 2)) << 3));
    glds16(Kt + ko, (unsigned)__builtin_amdgcn_readfirstlane((int)(ring_addr + koff + wid * 1024)));
    glds16(Vt + vo, (unsigned)__builtin_amdgcn_readfirstlane((int)(ring_addr + voff + wid * 1024)));
}
#define ATT_BAR() do { __builtin_amdgcn_sched_barrier(0); asm volatile("s_waitcnt lgkmcnt(0)" ::: "memory"); if (!(DBG & 8)) __builtin_amdgcn_s_barrier(); asm volatile("" ::: "memory"); __builtin_amdgcn_sched_barrier(0); } while (0)
#define ATT_WAIT_BAR(more) do { __builtin_amdgcn_sched_barrier(0); if (more) asm volatile("s_waitcnt vmcnt(2) lgkmcnt(0)" ::: "memory"); else asm volatile("s_waitcnt vmcnt(0) lgkmcnt(0)" ::: "memory"); __builtin_amdgcn_s_barrier(); asm volatile("" ::: "memory"); __builtin_amdgcn_sched_barrier(0); } while (0)
constexpr unsigned TT_ALWAYS = 1u << 12, TT_CAUSAL = 1u << 13, TT_LOWER = 1u << 16;
template <bool HAS_SEL, int DBG = 0> __device__ __forceinline__ void run_tiles(LAS unsigned char* ring, LAS const unsigned* tab, int n, const bf16* Kb, const bf16* Vb, bf16x8 (&q)[4],
                                                                      f32x16 (&o)[2], float& l, unsigned long long mymask, int tqbase, int wid, int lane, int r32, int hi, int vpo) {
    asm volatile("" : "+v"(q[0]), "+v"(q[1]), "+v"(q[2]), "+v"(q[3]));
    const bool hb = wid >= 4;
    const unsigned ring_addr = (unsigned)(size_t)ring;
    const int tq = tqbase + r32;
    float mhat = 0.f; bool started = false; l = 0.f;
    f32x16 negm = {0.f, 0.f, 0.f, 0.f, 0.f, 0.f, 0.f, 0.f, 0.f, 0.f, 0.f, 0.f, 0.f, 0.f, 0.f, 0.f};
    f32x16 p0 = negm, p1 = negm; bf16x8 pa[4]; if (DBG) { pa[0] = (bf16x8){0,0,0,0,0,0,0,0}; pa[1] = pa[0]; pa[2] = pa[0]; pa[3] = pa[0]; }
#define ATT_ISSUE(tt) do { const int ti_ = (tt) < n ? (tt) : n - 1; const unsigned dd_ = (unsigned)__builtin_amdgcn_readfirstlane((int)tab[ti_]); const size_t k0_ = (size_t)(64 * (dd_ & 63u)); \
        const int so_ = ((tt) & 3) * 16384; stage_kv_asm(ring_addr, so_, so_ + 8192, Kb + k0_ * LDP, Vb + k0_ * LDP, LDP, wid, lane); } while (0)
#define ATT_WAIT_BAR2() do { __builtin_amdgcn_sched_barrier(0); if (DBG & 4) asm volatile("s_waitcnt lgkmcnt(0)" ::: "memory"); else asm volatile("s_waitcnt vmcnt(2) lgkmcnt(0)" ::: "memory"); \
        if (!(DBG & 8)) __builtin_amdgcn_s_barrier(); asm volatile("" ::: "memory"); __builtin_amdgcn_sched_barrier(0); } while (0)
    ATT_ISSUE(0); ATT_ISSUE(1);
    ATT_WAIT_BAR2();
    if (hb) ATT_BAR();
    bool act_prev = false;
    unsigned d = (unsigned)__builtin_amdgcn_readfirstlane((int)tab[0]);
#pragma unroll 1
    for (int t = 0; t < n; ++t) {
        ATT_ISSUE(t + 2);
        if (act_prev && !(DBG & 2)) pv(o, ring + ((t - 1) & 3) * 16384 + 8192, vpo, pa);
        const int coff64 = (int)((d >> 14) & 3u) * 64;
        const bool causal = (d & TT_CAUSAL) != 0u;
        const bool act = !(causal && coff64 > tqbase + 31);
        if (act) {
            f32x16 cin = negm;
            if (HAS_SEL) { const bool sel = (d & TT_ALWAYS) || ((mymask >> ((d >> 6) & 63u)) & 1ull);
#pragma unroll
                for (int r = 0; r < 16; ++r) cin[r] = sel ? negm[r] : -INFINITY; }
            if (!(DBG & 2)) qkt(p0, p1, ring + (t & 3) * 16384, q, cin, r32, hi); else { p0 = cin; p1 = cin; }
        }
        ATT_WAIT_BAR2();
        if (act && !(DBG & 1)) {
            asm volatile("s_nop 15\n\ts_nop 7" : "+v"(p0), "+v"(p1));
            if (causal && coff64 + 63 > tqbase) mask_gt(p0, p1, tq - coff64, hi);
            if (d & TT_LOWER) mask_le(p0, p1, tq, hi);
            const float rm = pmax(tile_max3(p0, p1));
            const bool move = (rm > -INFINITY) && (!started || rm > THR);
            if (__builtin_expect(__any(move), 0)) {
                asm volatile("" ::: "memory");
                const float dl = move ? rm : 0.f;
                const float f = started ? __builtin_amdgcn_exp2f(-dl) : 1.0f;
                mhat += dl; l *= f; o[0] *= f; o[1] *= f;
#pragma unroll
                for (int r = 0; r < 16; ++r) { p0[r] -= dl; p1[r] -= dl; negm[r] = -mhat; }
                started = started || move;
            }
            asm volatile("" : "+v"(negm));
            float s = 0.f;
#pragma unroll
            for (int r = 0; r < 16; ++r) { p0[r] = __builtin_amdgcn_exp2f(p0[r]); p1[r] = __builtin_amdgcn_exp2f(p1[r]); s += p0[r] + p1[r]; }
            l += s;
            pack_p(pa, p0, p1);
        }
        act_prev = act;
        d = (unsigned)__builtin_amdgcn_readfirstlane((int)tab[t + 1 < n ? t + 1 : n - 1]);
        ATT_BAR();
    }
    if (act_prev && !(DBG & 2)) pv(o, ring + ((n - 1) & 3) * 16384 + 8192, vpo, pa);
    __builtin_amdgcn_sched_barrier(0); asm volatile("s_waitcnt vmcnt(0)" ::: "memory");
    ATT_BAR();
    if (!hb) ATT_BAR();
#undef ATT_ISSUE
#undef ATT_WAIT_BAR2
}

__device__ __forceinline__ void nsa_item(LAS unsigned char* lds, const bf16* P, const bf16* QR, const float* GN, const bf16* KC, const bf16* VC, bf16* YN,
                                         int b, int g, int tb, int wid, int lane_in, int tid_in) {
    int lane = lane_in, tid = tid_in; asm volatile("" : "+v"(lane), "+v"(tid));
    const int r = wid & 3, ts = wid >> 2, h = 4 * g + r, r32 = lane & 31, hi = lane >> 5;
    const int tq = 32 * ts + r32, t = 64 * tb + tq; const size_t row = (size_t)b * SEQ + t;
    const float g0 = GN[row * 32 + 3 * h], g1 = GN[row * 32 + 3 * h + 1], g2 = GN[row * 32 + 3 * h + 2];
    LAS unsigned* maskw = (LAS unsigned*)(lds + MISC_OFF + 256);
    LAS unsigned* uni = (LAS unsigned*)(lds + MISC_OFF + 768);
    const int vpo = vpo_of(lane);
    const f32x16 zero16 = {0.f, 0.f, 0.f, 0.f, 0.f, 0.f, 0.f, 0.f, 0.f, 0.f, 0.f, 0.f, 0.f, 0.f, 0.f, 0.f};
    f32x16 y[2] = {zero16, zero16};
    if (tid < 128) maskw[tid] = 0u;
    if (tid == 128) { uni[0] = 0u; uni[1] = 0u; }
    __syncthreads();
    const int ntc = ((4 * tb + 2) >> 6) + 1;
    {
        bf16x8 qc[4];
#pragma unroll
        for (int d0 = 0; d0 < 4; ++d0) qc[d0] = *(const bf16x8*)(P + row * LDP + 64 * h + 16 * d0 + 8 * hi);
        const bf16* kcb = KC + (size_t)(b * 2 + g) * 256 * 64; const bf16* vcb = VC + (size_t)(b * 2 + g) * 256 * 64;
#pragma unroll 1
        for (int T = 0; T < ntc; ++T) stage_kv(lds, T * 8192, 32768 + T * 8192, kcb + (size_t)T * 64 * 64, vcb + (size_t)T * 64 * 64, 64, wid, lane);
        __syncthreads();
        const int nlim = t >= 31 ? ((t - 31) >> 4) : -1;
        float m = -1e30f;
#pragma unroll 1
        for (int T = 0; T < ntc; ++T) { f32x16 p0, p1; qkt(p0, p1, lds + T * 8192, qc, zero16, r32, hi); mask_gt(p0, p1, nlim - 64 * T, hi); m = fmaxf(m, tile_max(p0, p1)); }
        m = pmax(m);
        const float mc = -m * C2; float l = 0.f; f32x16 o[2] = {zero16, zero16};
        float carry = 0.f;
        LAS float* Fb = (LAS float*)(lds + 65536) + (wid * 32 + r32) * 65 + hi;
#pragma unroll 1
        for (int T = 0; T < ntc; ++T) {
            f32x16 p0, p1; qkt(p0, p1, lds + T * 8192, qc, zero16, r32, hi); mask_gt(p0, p1, nlim - 64 * T, hi);
            float s = 0.f;
#pragma unroll
            for (int rr = 0; rr < 16; ++rr) { p0[rr] = __builtin_amdgcn_exp2f(fmaf(p0[rr], C2, mc)); p1[rr] = __builtin_amdgcn_exp2f(fmaf(p1[rr], C2, mc)); s += p0[rr] + p1[rr]; }
            l += s;
#pragma unroll
            for (int ph = 0; ph < 2; ++ph)
#pragma unroll
                for (int i = 0; i < 4; ++i) {
                    const float e0 = ph ? p1[4 * i] : p0[4 * i], e1 = ph ? p1[4 * i + 1] : p0[4 * i + 1], e2 = ph ? p1[4 * i + 2] : p0[4 * i + 2], e3 = ph ? p1[4 * i + 3] : p0[4 * i + 3];
                    const float Lr = __shfl_xor(e3, 32);
                    Fb[16 * T + 8 * ph + 2 * i] = ((e0 + e1) + (e2 + e3)) + (hi ? Lr : carry);
                    carry = Lr;
                }
            bf16x8 pa[4]; pack_p(pa, p0, p1);
            pv(o, lds + 32768 + T * 8192, vpo, pa);
        }
        const float lt = psum(l); const float inv = lt > 0.f ? 1.0f / lt : 0.f;
        y[0] = o[0] * (g0 * inv); y[1] = o[1] * (g0 * inv);
        if (hi == 0) ((LAS float*)(lds + 65536 + 66560))[wid * 32 + r32] = inv;
    }
    __syncthreads();
    {
        const int tk = tid >> 3, sub = tid & 7;
        LAS const float* F0 = (LAS const float*)(lds + 65536) + ((tk >> 5) * 128 + (tk & 31)) * 65;
        LAS float* imp = (LAS float*)lds + tk * 68;
        LAS const float* ivp = (LAS const float*)(lds + 65536 + 66560) + (tk >> 5) * 128 + (tk & 31);
        const float iv0 = ivp[0], iv1 = ivp[32], iv2 = ivp[64], iv3 = ivp[96];
        float vj[8];
#pragma unroll
        for (int i = 0; i < 8; ++i) { const int j = 8 * sub + i;
            float v = ((F0[j] * iv0 + F0[32 * 65 + j] * iv1) + F0[64 * 65 + j] * iv2) + F0[96 * 65 + j] * iv3;
            if (j == 0 || j == tb || j == tb - 1) v = INFINITY;
            if (j > tb) v = -INFINITY;
            vj[i] = v; }
        *(LAS f32x4*)(imp + 8 * sub) = (f32x4){vj[0], vj[1], vj[2], vj[3]}; *(LAS f32x4*)(imp + 8 * sub + 4) = (f32x4){vj[4], vj[5], vj[6], vj[7]};
        __syncthreads();
        int rank[8];
#pragma unroll
        for (int i = 0; i < 8; ++i) rank[i] = 0;
#pragma unroll 2
        for (int c4 = 0; c4 < 16; ++c4) {
            const f32x4 vv = *(LAS const f32x4*)(imp + 4 * c4);
#pragma unroll
            for (int e = 0; e < 4; ++e) { const int jj = 4 * c4 + e; const float x = vv[e];
#pragma unroll
                for (int i = 0; i < 8; ++i) rank[i] += (int)(x > vj[i]) | ((int)(x == vj[i]) & (int)(jj < 8 * sub + i)); }
        }
        unsigned bits = 0u;
#pragma unroll
        for (int i = 0; i < 8; ++i) if (rank[i] < 16 && 8 * sub + i <= tb) bits |= 1u << i;
        bits <<= 8 * (sub & 3);
        __hip_atomic_fetch_or(maskw + 2 * tk + (sub >> 2), bits, __ATOMIC_RELAXED, __HIP_MEMORY_SCOPE_WORKGROUP);
        __hip_atomic_fetch_or(uni + (sub >> 2), bits, __ATOMIC_RELAXED, __HIP_MEMORY_SCOPE_WORKGROUP);
        __syncthreads();
    }
    const unsigned long long mymask = ((unsigned long long)maskw[2 * tq + 1] << 32) | maskw[2 * tq];
    const unsigned long long um = ((unsigned long long)(unsigned)__builtin_amdgcn_readfirstlane((int)uni[1]) << 32) | (unsigned)__builtin_amdgcn_readfirstlane((int)uni[0]);
    const size_t brow = (size_t)b * SEQ;
    bf16x8 qr[4];
#pragma unroll
    for (int d0 = 0; d0 < 4; ++d0) qr[d0] = *(const bf16x8*)(QR + row * 512 + 64 * h + 16 * d0 + 8 * hi);
    LAS float* ypark = (LAS float*)(lds + 65536) + tid;
#pragma unroll
    for (int r = 0; r < 16; ++r) { ypark[r * 512] = y[0][r]; ypark[(16 + r) * 512] = y[1][r]; }
    LAS unsigned* tab = (LAS unsigned*)(lds + MISC_OFF + 1024);
    {
        if (tid < 64 && ((um >> tid) & 1ull)) tab[__builtin_popcountll(um & ((1ull << tid) - 1ull))] = (unsigned)tid | ((unsigned)tid << 6) | (tid == tb ? TT_CAUSAL : 0u);
        __syncthreads();
        float l; f32x16 o[2] = {zero16, zero16};
        run_tiles<true>(lds, tab, __builtin_popcountll(um), P + brow * LDP + 768 + 64 * g, P + brow * LDP + 896 + 64 * g, qr, o, l, mymask, 32 * ts, wid, lane, r32, hi, vpo);
        const float lt = psum(l); const float sc = lt > 0.f ? g1 / lt : 0.f;
#pragma unroll
        for (int r = 0; r < 16; ++r) { ypark[r * 512] += o[0][r] * sc; ypark[(16 + r) * 512] += o[1][r] * sc; }
    }
    {
        const int j0 = tb >= 8 ? tb - 8 : 0, nw = tb - j0 + 1;
        if (tid < nw) { const int j = j0 + tid; tab[tid] = (unsigned)j | TT_ALWAYS | (j == tb ? TT_CAUSAL : 0u) | ((tb >= 8 && j == tb - 8) ? TT_LOWER : 0u); }
        __syncthreads();
        float l; f32x16 o[2] = {zero16, zero16};
        run_tiles<false>(lds, tab, nw, P + brow * LDP + 1024 + 64 * g, P + brow * LDP + 1152 + 64 * g, qr, o, l, 0ull, 32 * ts, wid, lane, r32, hi, vpo);
        const float lt = psum(l); const float sc = lt > 0.f ? g2 / lt : 0.f;
#pragma unroll
        for (int r = 0; r < 16; ++r) { y[0][r] = ypark[r * 512] + o[0][r] * sc; y[1][r] = ypark[(16 + r) * 512] + o[1][r] * sc; }
    }
    store_y(YN + row * 512 + 64 * h, y, hi);
}

template <int DBG = 0> __device__ __forceinline__ void moba_item(LAS unsigned char* lds, const bf16* P, const bf16* KMH, const bf16* KML, bf16* YM, int b, int h, int ob, int wid, int lane_in, int tid_in) {
    int lane = lane_in, tid = tid_in; asm volatile("" : "+v"(lane), "+v"(tid));
    const int r32 = lane & 31, hi = lane >> 5, tq = 32 * wid + r32, t = 256 * ob + tq; const size_t row = (size_t)b * SEQ + t;
    bf16x8 qr[4];
#pragma unroll
    for (int d0 = 0; d0 < 4; ++d0) qr[d0] = *(const bf16x8*)(P + row * LDP + 1280 + 64 * h + 16 * d0 + 8 * hi);
    LAS unsigned* uni = (LAS unsigned*)(lds + MISC_OFF + 776);
    const int vpo = vpo_of(lane);
    const f32x16 zero16 = {0.f, 0.f, 0.f, 0.f, 0.f, 0.f, 0.f, 0.f, 0.f, 0.f, 0.f, 0.f, 0.f, 0.f, 0.f, 0.f};
    if (tid == 0) uni[0] = 0u;
    __syncthreads();
    unsigned mymask = 0u;
    if (ob > 0) {
        f32x16 ga = zero16;
        const bf16* kh = KMH + ((size_t)(b * 8 + h) * 16 + (r32 & 15)) * 64 + 8 * hi; const bf16* kl = KML + ((size_t)(b * 8 + h) * 16 + (r32 & 15)) * 64 + 8 * hi;
#pragma unroll
        for (int d0 = 0; d0 < 4; ++d0) { const bf16x8 ah = *(const bf16x8*)(kh + 16 * d0), al = *(const bf16x8*)(kl + 16 * d0);
            ga = __builtin_amdgcn_mfma_f32_32x32x16_bf16(ah, qr[d0], ga, 0, 0, 0); ga = __builtin_amdgcn_mfma_f32_32x32x16_bf16(al, qr[d0], ga, 0, 0, 0); }
        float gv[16];
#pragma unroll
        for (int rr = 0; rr < 8; ++rr) { const float a = ga[rr], bb = __shfl_xor(a, 32); const int n0 = (rr & 3) + 8 * (rr >> 2); gv[n0] = hi ? bb : a; gv[n0 + 4] = hi ? a : bb; }
#pragma unroll
        for (int pick = 0; pick < 3; ++pick) { float best = -INFINITY; int bi = -1;
#pragma unroll
            for (int n = 0; n < 16; ++n) if (n < ob && !((mymask >> n) & 1u) && gv[n] > best) { best = gv[n]; bi = n; }
            if (bi >= 0) mymask |= 1u << bi; }
        unsigned umw = 0u;
#pragma unroll
        for (int n = 0; n < 16; ++n) if (__ballot((mymask >> n) & 1u)) umw |= 1u << n;
        if (lane == 0) __hip_atomic_fetch_or(uni, umw, __ATOMIC_RELAXED, __HIP_MEMORY_SCOPE_WORKGROUP);
    }
    __syncthreads();
    const unsigned um = (unsigned)__builtin_amdgcn_readfirstlane((int)uni[0]);
    const size_t brow = (size_t)b * SEQ;
    LAS unsigned* tab = (LAS unsigned*)(lds + MISC_OFF + 1024);
    if (tid < 4) tab[tid] = (unsigned)(4 * ob + tid) | TT_ALWAYS | TT_CAUSAL | ((unsigned)tid << 14);
    if (tid >= 64 && tid < 80) { const int nb = tid - 64;
        if ((um >> nb) & 1u) { const int base = 4 + 4 * __builtin_popcount(um & ((1u << nb) - 1u));
#pragma unroll
            for (int kt = 0; kt < 4; ++kt) tab[base + kt] = (unsigned)(4 * nb + kt) | ((unsigned)nb << 6); } }
    __syncthreads();
    float l; f32x16 o[2] = {zero16, zero16};
    run_tiles<true, DBG>(lds, tab, 4 + 4 * __builtin_popcount(um), P + brow * LDP + 1792 + 64 * h, P + brow * LDP + 2304 + 64 * h, qr, o, l, (unsigned long long)mymask, 32 * wid, wid, lane, r32, hi, vpo);
    f32x16 y[2] = {zero16, zero16};
    fin_add(y, o, l, 1.0f);
    store_y(YM + row * 512 + 64 * h, y, hi);
}
}

__device__ __forceinline__ float gelu_tanh(float x) { const float y = 0.7978845608028654f * (x + 0.044715f * x * x * x); const float e = __expf(2.f * y); const float th = 1.f - 2.f / (e + 1.f); return 0.5f * x * (1.f + th); }
__device__ __forceinline__ void cmp_bias_item(LAS unsigned char* lds, const float* pe, const float* w1, float* biasout, int tid) {
    LAS float* bp = (LAS float*)lds;
    const int n = tid & 63, pt = tid >> 6; float s = 0.f;
#pragma unroll 8
    for (int k = 256 * pt; k < 256 * pt + 256; ++k) s += pe[k] * w1[(size_t)k * 64 + n];
    bp[pt * 64 + n] = s;
    __syncthreads();
    if (tid < 64) { float t = 0.f;
#pragma unroll
        for (int w = 0; w < 8; ++w) t += bp[w * 64 + tid];
        biasout[tid] = t; }
    __syncthreads();
}
__device__ __forceinline__ void compress_item(LAS unsigned char* lds, const bf16* P, const bf16* W1T, const float* bias, const float* w2, bf16* OUT, int kv, int b, int g, int rt, int wid, int lane, int tid) {
    LAS float* part = (LAS float*)lds;
    LAS float* Hs = (LAS float*)(lds + 65536);
    LAS float* W2s = (LAS float*)(lds + 65536 + 8192);
    const int r32 = lane & 31, hi = lane >> 5;
    __syncthreads();
#pragma unroll
    for (int jj = 0; jj < 2; ++jj) *(LAS f32x4*)(W2s + 4 * (tid + 512 * jj)) = *(const f32x4*)(w2 + 4 * (tid + 512 * jj));
    const bf16* Asrc = P + (size_t)b * SEQ * LDP + 512 + 128 * kv + 64 * g;
    const int rowi = rt * 32 + r32, rowc = rowi < 255 ? rowi : 254;
    f32x16 c0 = {0.f, 0.f, 0.f, 0.f, 0.f, 0.f, 0.f, 0.f, 0.f, 0.f, 0.f, 0.f, 0.f, 0.f, 0.f, 0.f}, c1 = c0;
#pragma unroll 8
    for (int ks = 0; ks < 16; ++ks) {
        const int l = wid * 4 + (ks >> 2), d = (ks & 3) * 16 + 8 * hi, k = wid * 256 + ks * 16 + 8 * hi;
        const bf16x8 a = *(const bf16x8*)(Asrc + (size_t)(16 * rowc + l) * LDP + d);
        const bf16x8 b0 = *(const bf16x8*)(W1T + (size_t)r32 * 2048 + k), b1 = *(const bf16x8*)(W1T + (size_t)(32 + r32) * 2048 + k);
        c0 = __builtin_amdgcn_mfma_f32_32x32x16_bf16(a, b0, c0, 0, 0, 0); c1 = __builtin_amdgcn_mfma_f32_32x32x16_bf16(a, b1, c1, 0, 0, 0);
    }
#pragma unroll
    for (int r = 0; r < 16; ++r) { const int i = att::crow(r, hi); part[(wid * 32 + i) * 64 + r32] = c0[r]; part[(wid * 32 + i) * 64 + 32 + r32] = c1[r]; }
    __syncthreads();
#pragma unroll
    for (int jj = 0; jj < 4; ++jj) { const int e = tid + 512 * jj, n = e & 63; float s = 0.f;
#pragma unroll
        for (int w = 0; w < 8; ++w) s += part[w * 2048 + e];
        Hs[e] = gelu_tanh(s + bias[n]); }
    __syncthreads();
#pragma unroll
    for (int jj = 0; jj < 4; ++jj) { const int e = tid + 512 * jj, i = e >> 6, c = e & 63; float s = 0.f;
#pragma unroll 16
        for (int j = 0; j < 64; ++j) s += Hs[i * 64 + j] * W2s[j * 64 + c];
        const int ro = rt * 32 + i;
        OUT[((size_t)(b * 2 + g) * 256 + ro) * 64 + c] = (ro < 255) ? (bf16)f2bf(s) : (bf16)0; }
}
__device__ __forceinline__ void kmean_item(LAS unsigned char* lds, const bf16* P, bf16* KMH, bf16* KML, int b, int n, int tid) {
    LAS float* ps = (LAS float*)lds;
    const int cg = tid & 63, rg = tid >> 6;
    const bf16* src = P + ((size_t)b * SEQ + 256 * n + 32 * rg) * LDP + 1792 + 8 * cg;
    float a[8] = {0.f, 0.f, 0.f, 0.f, 0.f, 0.f, 0.f, 0.f};
    __syncthreads();
#pragma unroll 8
    for (int i = 0; i < 32; ++i) { const v4u w = *(const v4u*)(src + (size_t)i * LDP);
        a[0] += bflo(w.x); a[1] += bfhi(w.x); a[2] += bflo(w.y); a[3] += bfhi(w.y); a[4] += bflo(w.z); a[5] += bfhi(w.z); a[6] += bflo(w.w); a[7] += bfhi(w.w); }
#pragma unroll
    for (int j = 0; j < 8; ++j) ps[rg * 512 + 8 * cg + j] = a[j];
    __syncthreads();
    float s = 0.f;
#pragma unroll
    for (int w = 0; w < 8; ++w) s += ps[w * 512 + tid];
    s *= (1.0f / 256.0f);
    const unsigned hb = f2bf(s); const float hf = __uint_as_float(hb << 16);
    const int h = tid >> 6, d = tid & 63; const size_t o = ((size_t)(b * 8 + h) * 16 + n) * 64 + d;
    KMH[o] = (bf16)hb; KML[o] = (bf16)f2bf(s - hf);
}

#ifndef MK_DUMMY_MOBA
#define MK_DUMMY_MOBA 0
#endif
#ifndef MK_REP_NSA
#define MK_REP_NSA 0
#endif
#ifndef MK_REP_MOBA
#define MK_REP_MOBA 0
#endif
#ifndef MK_REP
#define MK_REP 0
#endif
#ifndef MK_PH
#define MK_PH 0x3ff
#endif
struct Args { const float* in[16]; float* out; unsigned char* ws; };
#ifndef MK_SKIP_NSA
#define MK_SKIP_NSA 0
#endif
#ifndef MK_SKIP_MOBA
#define MK_SKIP_MOBA 0
#endif
__global__ void __launch_bounds__(NWAVES * 64, 2) mega_fwd(Args a) {
    extern __shared__ __attribute__((aligned(16))) unsigned char lds_raw[];
    LAS unsigned char* lds = (LAS unsigned char*)lds_raw;
    const int tid = threadIdx.x, lane = tid & 63, wave = __builtin_amdgcn_readfirstlane(tid >> 6);
    const int G = gridDim.x, bx = blockIdx.x; const int vcu = (G % 8 == 0) ? (bx % 8) * (G / 8) + bx / 8 : bx;
    unsigned char* ws = a.ws;
    const float* x = a.in[0]; const float* norm1_g = a.in[1]; const float* w_in = a.in[2]; const float* pe_k = a.in[3]; const float* pe_v = a.in[4];
    const float* ck_w1 = a.in[5]; const float* ck_w2 = a.in[6]; const float* cv_w1 = a.in[7]; const float* cv_w2 = a.in[8];
    const float* w_upn = a.in[9]; const float* w_upm = a.in[10]; const float* w_out = a.in[11]; const float* norm2_g = a.in[12];
    const float* w_ff1 = a.in[13]; const float* w_ff2 = a.in[14]; const float* normf_g = a.in[15];
    float* out = a.out;
    bf16* WIN = (bf16*)(ws + WS_WIN); bf16* WUPN = (bf16*)(ws + WS_WUPN); bf16* WUPM = (bf16*)(ws + WS_WUPM); bf16* WOUT = (bf16*)(ws + WS_WOUT);
    bf16* WFF1 = (bf16*)(ws + WS_WFF1); bf16* WFF2 = (bf16*)(ws + WS_WFF2); bf16* WC1K = (bf16*)(ws + WS_WC1K); bf16* WC1V = (bf16*)(ws + WS_WC1V);
    float* ROPE = (float*)(ws + WS_ROPE); bf16* KC = (bf16*)(ws + WS_KC); bf16* VC = (bf16*)(ws + WS_VC); bf16* KMH = (bf16*)(ws + WS_KMH); bf16* KML = (bf16*)(ws + WS_KML);
    float* CBIAS = (float*)(ws + WS_KML + 192 * 1024); float* SSQ = (float*)(ws + WS_SSQ);
    float* GN = (float*)(ws + WS_GN); bf16* QR = (bf16*)(ws + WS_QR); bf16* HN = (bf16*)(ws + WS_HN); bf16* YN = (bf16*)(ws + WS_YN); bf16* YM = (bf16*)(ws + WS_YM);
    bf16* MIX = (bf16*)(ws + WS_MIX); bf16* P = (bf16*)(ws + WS_P); bf16* U = (bf16*)(ws + WS_U);
    gu32* ctl = (gu32*)(ws + WS_CTL);

    for (int u = tid; u < (LDS_BYTES - MISC_OFF) / 4; u += NWAVES * 64) ((LAS unsigned*)(lds + MISC_OFF))[u] = 0u;
    __syncthreads();
    XcdBarrier bar = xcd_barrier_post((unsigned*)(ctl + CW_BAR), (volatile LAS unsigned*)(lds + MISC_OFF) + 8);

#if (MK_PH >> 0) & 1
    for (int rep_ = 0; rep_ < 1 + ((MK_REP >> 0) & 1); ++rep_) {
    {
        LAS float* scr = (LAS float*)(lds + wave * 16384);
        const int gw = vcu * NWAVES + wave, NGW = G * NWAVES;
        constexpr int I_WIN = 16 * 160, I_UP = 8 * 32, I_OUT = 16 * 32, I_FF1 = 16 * 128, I_FF2 = 64 * 32, I_C1 = 32 * 2;
        constexpr int NITEMS = I_WIN + 2 * I_UP + I_OUT + I_FF1 + I_FF2 + 2 * I_C1;
        for (int it = gw; it < NITEMS; it += NGW) {
            int r = it;
            if (r < I_WIN) { transpose_item(w_in, 1024, INW, NPROJ, WIN, scr, r, lane, true); continue; } r -= I_WIN;
            if (r < I_UP) { transpose_item(w_upn, 512, 1024, 1024, WUPN, scr, r, lane, false); continue; } r -= I_UP;
            if (r < I_UP) { transpose_item(w_upm, 512, 1024, 1024, WUPM, scr, r, lane, false); continue; } r -= I_UP;
            if (r < I_OUT) { transpose_item(w_out, 1024, 1024, 1024, WOUT, scr, r, lane, false); continue; } r -= I_OUT;
            if (r < I_FF1) { transpose_item(w_ff1, 1024, 4096, 4096, WFF1, scr, r, lane, false); continue; } r -= I_FF1;
            if (r < I_FF2) { transpose_item(w_ff2, 4096, 1024, 1024, WFF2, scr, r, lane, false); continue; } r -= I_FF2;
            if (r < I_C1) { transpose_item(ck_w1, 2048, 64, 64, WC1K, scr, r, lane, false); continue; } r -= I_C1;
            transpose_item(cv_w1, 2048, 64, 64, WC1V, scr, r, lane, false);
        }
        for (int idx = gw * 64 + lane; idx < SEQ * 8; idx += NGW * 64) {
            const int pos = idx >> 3, i = idx & 7;
            const float inv = powf(500000.0f, -(float)i * 0.125f), ang = (float)pos * inv;
            ROPE[pos * 16 + i] = cosf(ang); ROPE[pos * 16 + 8 + i] = sinf(ang);
        }
        for (int m = gw; m < NTOK; m += NGW) rms_row<false>(x + (size_t)m * DMODEL, norm1_g, HN + (size_t)m * DMODEL, lane);
        if (bx < 2) { __syncthreads(); cmp_bias_item(lds, bx ? pe_v : pe_k, bx ? cv_w1 : ck_w1, CBIAS + 64 * bx, tid); }
    }
    xcd_barrier(bar);

    }
#endif
#if (MK_PH >> 1) & 1
    for (int rep_ = 0; rep_ < 1 + ((MK_REP >> 1) & 1); ++rep_) {
    {
        pg8::Gemm g{HN, WIN, HN, WIN, NTOK, NPROJ, DMODEL}; pg8::StaticOrder S; S.init(NTOK, NPROJ, G, bx);
        EpiProj E{P, QR, GN, ROPE};
        pg8::gemm_phase<EpiProj, pg8::StaticOrder, true, true>(lds, g, S, E);
    }
    xcd_barrier(bar);

    }
#endif
#if (MK_PH >> 2) & 1
    for (int rep_ = 0; rep_ < 1 + ((MK_REP >> 2) & 1); ++rep_) {
    for (int it = vcu; it < 256; it += G) {
        const int kv = it >> 7, b = (it >> 4) & 7, g = (it >> 3) & 1, rt = it & 7;
        compress_item(lds, P, kv ? WC1V : WC1K, CBIAS + 64 * kv, kv ? cv_w2 : ck_w2, kv ? VC : KC, kv, b, g, rt, wave, lane, tid);
    }
    for (int it = (vcu + 128) % G; it < 128; it += G) kmean_item(lds, P, KMH, KML, it >> 4, it & 15, tid);
    xcd_barrier(bar);

    }
#endif
#if (MK_PH >> 3) & 1
    for (int rep_ = 0; rep_ < 1 + ((MK_REP >> 3) & 1); ++rep_) {
    {
#if MK_SKIP_NSA
        for (size_t i = (size_t)bx * 512 + tid; i < (size_t)NTOK * 512 / 8; i += (size_t)G * 512) ((v4u*)YN)[i] = (v4u){0u, 0u, 0u, 0u};
#else
        for (int rn_ = 0; rn_ < 1 + MK_REP_NSA; ++rn_)
        for (int it = vcu; it < 256; it += G) {
            const int bg = it >> 4, s = it & 15;
#pragma unroll 1
            for (int k = 0; k < 4; ++k) { const int tb = (k == 0) ? 63 - s : (k == 1) ? 32 + s : (k == 2) ? 31 - s : s;
                att::nsa_item(lds, P, QR, GN, KC, VC, YN, bg >> 1, bg & 1, tb, wave, lane, tid); }
        }
    }
#endif
#if MK_SKIP_MOBA
        for (size_t i = (size_t)bx * 512 + tid; i < (size_t)NTOK * 512 / 8; i += (size_t)G * 512) ((v4u*)YM)[i] = (v4u){0u, 0u, 0u, 0u};
#else
#if MK_DUMMY_MOBA
        for (int it = vcu; it < 256; it += G) {
            const int bh = it >> 2, s = it & 3;
#pragma unroll 1
            for (int k = 0; k < 4; ++k) { const int ob = (k == 0) ? 15 - s : (k == 1) ? 8 + s : (k == 2) ? 7 - s : s;
                att::moba_item<MK_DUMMY_MOBA>(lds, P, KMH, KML, MIX, bh >> 3, bh & 7, ob, wave, lane, tid); }
        }
#endif
        for (int rm_ = 0; rm_ < 1 + MK_REP_MOBA; ++rm_)
        for (int it = vcu; it < 256; it += G) {
            const int grp = it >> 4, j = it & 15;
#pragma unroll 1
            for (int k = 0; k < 4; ++k) { const int bh = grp * 4 + k; const int ob = (k & 1) ? 15 - j : j;
                att::moba_item(lds, P, KMH, KML, YM, bh >> 3, bh & 7, ob, wave, lane, tid); }
        }
#endif
    }
    xcd_barrier(bar);

#endif
#if (MK_PH >> 4) & 1
    for (int rep_ = 0; rep_ < 1 + ((MK_REP >> 4) & 1); ++rep_) {
    {
        pg8::Gemm g{YN, WUPN, YM, WUPM, NTOK, DMODEL, 512}; pg8::PairOrder S; S.init(NTOK, DMODEL, G, bx);
        EpiMerge E{P, MIX};
        pg8::gemm_phase<EpiMerge, pg8::PairOrder, true, true>(lds, g, S, E);
    }
    xcd_barrier(bar);

    }
#endif
#if (MK_PH >> 5) & 1
    for (int rep_ = 0; rep_ < 1 + ((MK_REP >> 5) & 1); ++rep_) {
    {
        pg8::Gemm g{MIX, WOUT, MIX, WOUT, NTOK, DMODEL, DMODEL}; pg8::StaticOrder S; S.init(NTOK, DMODEL, G, bx);
        EpiResNorm E{x, out, HN, norm2_g, SSQ};
        pg8::gemm_phase<EpiResNorm, pg8::StaticOrder, true, true>(lds, g, S, E);
    }
    xcd_barrier(bar);

    }
#endif
#if (MK_PH >> 7) & 1
    for (int rep_ = 0; rep_ < 1 + ((MK_REP >> 7) & 1); ++rep_) {
    {
        pg8::Gemm g{HN, WFF1, HN, WFF1, NTOK, DFF, DMODEL}; pg8::StaticOrder S; S.init(NTOK, DFF, G, bx);
        EpiRelu2 E{U, SSQ};
        pg8::gemm_phase<EpiRelu2, pg8::StaticOrder, true, true>(lds, g, S, E);
    }
    xcd_barrier(bar);

    }
#endif
#if (MK_PH >> 8) & 1
    for (int rep_ = 0; rep_ < 1 + ((MK_REP >> 8) & 1); ++rep_) {
    {
        pg8::Gemm g{U, WFF2, U, WFF2, NTOK, DMODEL, DFF}; pg8::StaticOrder S; S.init(NTOK, DMODEL, G, bx);
        EpiRes E{out, out};
        pg8::gemm_phase<EpiRes, pg8::StaticOrder, true, true>(lds, g, S, E);
    }
    xcd_barrier(bar);

    }
#endif
#if (MK_PH >> 9) & 1
    for (int rep_ = 0; rep_ < 1 + ((MK_REP >> 9) & 1); ++rep_) {
    {
        const int gw = vcu * NWAVES + wave, NGW = G * NWAVES;
        for (int m = gw; m < NTOK; m += NGW) rms_row<true>(out + (size_t)m * DMODEL, normf_g, out + (size_t)m * DMODEL, lane);
    }
    }
#endif
}

extern "C" void kernel_launch(void* const* d_in, const int* in_sizes, int n_in, void* d_out, int out_size, void* d_ws, size_t ws_size, hipStream_t stream) {
    static int grid = 0;
    if (grid == 0) {
        if (n_in != 16 || in_sizes[0] != NTOK * DMODEL || out_size != NTOK * DMODEL || ws_size < WS_END) {
            fprintf(stderr, "kernel_launch: unexpected shapes (n_in %d, in0 %d, out %d, ws %zu); nothing launched\n", n_in, n_in > 0 ? in_sizes[0] : -1, out_size, ws_size); grid = -1; return; }
        int dev = 0, cus = 0, per_cu = 0;
        if (hipGetDevice(&dev) != hipSuccess || hipDeviceGetAttribute(&cus, hipDeviceAttributeMultiprocessorCount, dev) != hipSuccess) { fprintf(stderr, "kernel_launch: device query failed\n"); grid = -1; return; }
        if (hipFuncSetAttribute((const void*)mega_fwd, hipFuncAttributeMaxDynamicSharedMemorySize, LDS_BYTES) != hipSuccess) { fprintf(stderr, "kernel_launch: hipFuncSetAttribute failed\n"); grid = -1; return; }
        if (hipOccupancyMaxActiveBlocksPerMultiprocessor(&per_cu, (const void*)mega_fwd, NWAVES * 64, LDS_BYTES) != hipSuccess || per_cu < 1)
            fprintf(stderr, "kernel_launch: note: occupancy query reports %d workgroups per CU\n", per_cu);
        (void)hipGetLastError();
        grid = cus;
    }
    if (grid < 0) return;
    if (hipMemsetAsync((char*)d_ws + WS_CTL, 0, CTL_ZERO_BYTES, stream) != hipSuccess) { fprintf(stderr, "kernel_launch: hipMemsetAsync failed\n"); return; }
    Args a{};
    for (int i = 0; i < 16; ++i) a.in[i] = (const float*)d_in[i];
    a.out = (float*)d_out; a.ws = (unsigned char*)d_ws;
    hipLaunchKernelGGL(mega_fwd, dim3(grid), dim3(NWAVES * 64), LDS_BYTES, stream, a);
    const hipError_t le = hipPeekAtLastError();
    if (le != hipSuccess) fprintf(stderr, "kernel_launch: launch failed: %s\n", hipGetErrorName(le));
}
```

```cpp
#include <hip/hip_runtime.h>
#include <cstdio>
#include <cstdint>
#include <cmath>
#ifndef MK_LAUNDER_GEMM
#define MK_LAUNDER_GEMM 1
#endif
#ifndef MK_KPHASE
#define MK_KPHASE 0
#endif
namespace pg8 {
#define PG8_LAS __attribute__((address_space(3)))
typedef unsigned short bf16_t;
typedef short bf16x8 __attribute__((ext_vector_type(8)));
typedef float f32x4 __attribute__((ext_vector_type(4)));
typedef unsigned u32x4 __attribute__((ext_vector_type(4)));
constexpr int BM = 256, BK = 64, HALF = 128, HTB = HALF * BK * 2  , STAGE_BYTES = 8 * HTB, NXCD = 8, WGM = 8;

__host__ __device__ __forceinline__ int lds_byte(int r, int c) { const int st = (r >> 4) * 2 + (c >> 5), rr = r & 15, cc = c & 31, ob = rr * 64 + cc * 2; return st * 1024 + (ob ^ (((ob >> 9) & 1) << 5)); }
__host__ __device__ __forceinline__ void stage_rc(int b, int& R, int& C) { const int st = b / 1024, sb = b % 1024, swz = sb ^ (((sb >> 9) & 1) << 5); R = (st >> 1) * 16 + swz / 64; C = (st & 1) * 32 + (swz % 64) / 2; }
__host__ __device__ __forceinline__ int perm32(int rho) { const int n = rho >> 4, i = rho & 15; return 8 * (i >> 2) + 4 * n + (i & 3); }

struct Unit { int pm, pn, src; };
struct Gemm { const bf16_t* A; const bf16_t* Bt; const bf16_t* A2; const bf16_t* Bt2; int M, N, K; };
struct StaticOrder {
    int nM, nN, nwg, G, c;
    __host__ __device__ void init(int M, int N, int G_, int c_) { nM = M / BM; nN = N / BM; nwg = nM * nN; G = G_; c = c_; }
    __host__ __device__ bool tile(long L, Unit& u) const {
        if (L >= nwg) return false;
        int wgid = (int)L; { const int q = nwg / NXCD, r = nwg % NXCD, xcd = wgid % NXCD, off = wgid / NXCD; wgid = (xcd < r ? xcd * (q + 1) : r * (q + 1) + (xcd - r) * q) + off; }
        const int nig = WGM * nN, gid = wgid / nig, fm = gid * WGM, gsz = (nM - fm) < WGM ? (nM - fm) : WGM;
        u.pm = fm + ((wgid % nig) % gsz); u.pn = (wgid % nig) / gsz; return true;
    }
    __host__ __device__ bool next(int i, Unit& u) const { u.src = 0; return tile((long)i * G + c, u); }
    __device__ __forceinline__ void a_ready(const Unit&) const {}
    __device__ __forceinline__ void done(const Unit&) const {}
};
struct PairOrder : StaticOrder {
    __host__ __device__ bool next(int i, Unit& u) const { u.src = i & 1; return tile((long)(i >> 1) * G + c, u); }
};
__device__ __forceinline__ unsigned cvt_pk_bf16(float lo, float hi) { unsigned r; asm volatile("v_cvt_pk_bf16_f32 %0, %1, %2" : "=v"(r) : "v"(lo), "v"(hi)); return r; }
template <class Epi, class Sched, bool ALIGN_EPI = false, bool SP2 = false>
__device__ __forceinline__ void gemm_phase(PG8_LAS unsigned char* lds, const Gemm g, const Sched& S, const Epi& E) {
    int tid_ = threadIdx.x;
#if MK_LAUNDER_GEMM
    asm volatile("" : "+v"(tid_));
#endif
    const int tid = tid_, wid = __builtin_amdgcn_readfirstlane(tid >> 6), lane = tid & 63, wr = wid >> 2, wc = wid & 3, fr = lane & 15, fq = lane >> 4;
    const int K = g.K, nt = K / BK;
    unsigned voffA[2], voffB[2];
#pragma unroll
    for (int i = 0; i < 2; ++i) { int R, C; stage_rc(tid * 16 + i * 8192, R, C); const int Rb = Epi::PERM ? ((R & ~31) + perm32(R & 31)) : R;
        voffA[i] = (unsigned)(R * K + C) * 2u; voffB[i] = (unsigned)(Rb * K + C) * 2u; }
    const size_t kstep = (size_t)(BK * 2);
    const size_t hstep = (size_t)HALF * K * 2;
    const size_t tstep = 2 * hstep;
    const unsigned ldsw = (unsigned)wid * 1024u;
    const int aoff = lds_byte(wr * 64 + fr, fq * 8), boff = lds_byte(wc * 32 + fr, fq * 8);
#define PG8_SA(b, h) (((b) * 2 + (h)) * HTB)
#define PG8_SB(b, h) ((4 + (b) * 2 + (h)) * HTB)
#define PG8_STAGE(bufoff, gbase, voff) do { _Pragma("unroll") for (int _i = 0; _i < 2; ++_i) \
        __builtin_amdgcn_global_load_lds((const unsigned*)((const char*)(gbase) + (voff)[_i]), (PG8_LAS unsigned*)(lds + (bufoff) + ldsw + _i * 8192), 16, 0, 0); } while (0)
#define PG8_LDA(dst, b, h) do { _Pragma("unroll") for (int m = 0; m < 4; ++m) _Pragma("unroll") for (int k = 0; k < 2; ++k) dst[m][k] = *(const PG8_LAS bf16x8*)(lds + PG8_SA(b, h) + aoff + m * 2048 + k * 1024); } while (0)
#define PG8_LDB(dst, b, h) do { _Pragma("unroll") for (int n = 0; n < 2; ++n) _Pragma("unroll") for (int k = 0; k < 2; ++k) dst[n][k] = *(const PG8_LAS bf16x8*)(lds + PG8_SB(b, h) + boff + n * 2048 + k * 1024); } while (0)
#define PG8_MMA(ai, bj, At, Bt) do { __builtin_amdgcn_s_setprio(1); _Pragma("unroll") for (int m = 0; m < 4; ++m) _Pragma("unroll") for (int n = 0; n < 2; ++n) _Pragma("unroll") for (int k = 0; k < 2; ++k) \
        acc[ai][bj][m][n] = __builtin_amdgcn_mfma_f32_16x16x32_bf16(Bt[n][k], At[m][k], acc[ai][bj][m][n], 0, 0, 0); __builtin_amdgcn_s_setprio(0); } while (0)
#define PG8_WAIT_V(n) asm volatile("s_waitcnt vmcnt(" #n ")" ::: "memory")
#define PG8_WAIT_L(n) asm volatile("s_waitcnt lgkmcnt(" #n ")" ::: "memory")
#define PG8_BAR __builtin_amdgcn_s_barrier()
#define PG8_SCHED __builtin_amdgcn_sched_barrier(0)
    Unit cur, nxt; int ui = 0;
    if (!S.next(0, cur)) return;
    f32x4 acc[2][2][4][2];
#pragma unroll
    for (int a = 0; a < 2; ++a)
#pragma unroll
        for (int b = 0; b < 2; ++b)
#pragma unroll
            for (int m = 0; m < 4; ++m)
#pragma unroll
                for (int n = 0; n < 2; ++n) acc[a][b][m][n] = (f32x4){0.f, 0.f, 0.f, 0.f};
    bf16x8 At[4][2], B0[2][2], B1[2][2];
    const char* cA = (const char*)(cur.src ? g.A2 : g.A) + (size_t)cur.pm * tstep; const char* cB = (const char*)(cur.src ? g.Bt2 : g.Bt) + (size_t)cur.pn * tstep;
    S.a_ready(cur);
    if constexpr (SP2) {
        PG8_STAGE(PG8_SB(0, 0), cB, voffB); PG8_STAGE(PG8_SB(0, 1), cB + hstep, voffB); PG8_STAGE(PG8_SA(0, 0), cA, voffA); PG8_STAGE(PG8_SA(0, 1), cA + hstep, voffA);
        if (wr == 1) PG8_BAR;
        PG8_WAIT_V(2); PG8_BAR;
        PG8_STAGE(PG8_SB(1, 0), cB + kstep, voffB); PG8_STAGE(PG8_SA(1, 0), cA + kstep, voffA); PG8_STAGE(PG8_SB(1, 1), cB + hstep + kstep, voffB);
        PG8_WAIT_V(6); PG8_BAR;
    } else {
        PG8_STAGE(PG8_SB(0, 0), cB, voffB); PG8_STAGE(PG8_SA(0, 0), cA, voffA); PG8_STAGE(PG8_SB(0, 1), cB + hstep, voffB); PG8_STAGE(PG8_SA(0, 1), cA + hstep, voffA);
        if (wr == 1) PG8_BAR;
        PG8_WAIT_V(4); PG8_BAR;
        PG8_STAGE(PG8_SB(1, 0), cB + kstep, voffB); PG8_STAGE(PG8_SA(1, 0), cA + kstep, voffA); PG8_STAGE(PG8_SB(1, 1), cB + hstep + kstep, voffB);
        PG8_WAIT_V(6); PG8_BAR;
    }
    for (;;) {
        const bool has_next = S.next(ui + 1, nxt);
        const char* nA = has_next ? (const char*)(nxt.src ? g.A2 : g.A) + (size_t)nxt.pm * tstep : cA; const char* nB = has_next ? (const char*)(nxt.src ? g.Bt2 : g.Bt) + (size_t)nxt.pn * tstep : cB;
        for (int t = 0; t < nt; t += 2) {
#if MK_KPHASE == 1
            asm volatile(".p2align 3" ::: "memory");
#elif MK_KPHASE == 2
            asm volatile(".p2align 3\n\ts_nop 0" ::: "memory");
#endif
            const bool last = (t == nt - 2);
            const char* a1 = cA + (size_t)(t + 1) * kstep;
            const char* a2 = last ? nA : cA + (size_t)(t + 2) * kstep; const char* b2 = last ? nB : cB + (size_t)(t + 2) * kstep;
            const char* a3 = a2 + kstep; const char* b3 = b2 + kstep;
            if (last && has_next) S.a_ready(nxt);
            if constexpr (SP2) {
            PG8_LDB(B0, 0, 0); PG8_LDB(B1, 0, 1); PG8_SCHED; PG8_LDA(At, 0, 0); PG8_STAGE(PG8_SA(1, 1), a1 + hstep, voffA);
            PG8_WAIT_V(8); PG8_WAIT_L(0); PG8_BAR; PG8_MMA(0, 0, At, B0); PG8_MMA(0, 1, At, B1); PG8_BAR; PG8_SCHED;
            PG8_LDA(At, 0, 1); PG8_STAGE(PG8_SB(0, 0), b2, voffB); PG8_STAGE(PG8_SB(0, 1), b2 + hstep, voffB); PG8_STAGE(PG8_SA(0, 0), a2, voffA);
            PG8_WAIT_V(8); PG8_WAIT_L(0); PG8_BAR; PG8_MMA(1, 0, At, B0); PG8_MMA(1, 1, At, B1); PG8_BAR; PG8_SCHED;
            PG8_LDB(B0, 1, 0); PG8_LDB(B1, 1, 1); PG8_SCHED; PG8_LDA(At, 1, 0); PG8_STAGE(PG8_SA(0, 1), a2 + hstep, voffA);
            PG8_WAIT_V(8); PG8_WAIT_L(0); PG8_BAR; PG8_MMA(0, 0, At, B0); PG8_MMA(0, 1, At, B1); PG8_BAR; PG8_SCHED;
            PG8_LDA(At, 1, 1); PG8_STAGE(PG8_SB(1, 0), b3, voffB); PG8_STAGE(PG8_SB(1, 1), b3 + hstep, voffB); PG8_STAGE(PG8_SA(1, 0), a3, voffA);
            PG8_WAIT_V(8); PG8_WAIT_L(0); PG8_BAR; PG8_MMA(1, 0, At, B0); PG8_MMA(1, 1, At, B1); PG8_BAR; PG8_SCHED;
            } else {
            PG8_LDB(B0, 0, 0); PG8_SCHED; PG8_LDA(At, 0, 0); PG8_STAGE(PG8_SA(1, 1), a1 + hstep, voffA);
            PG8_WAIT_L(8); PG8_BAR; PG8_WAIT_L(0); PG8_MMA(0, 0, At, B0); PG8_BAR; PG8_SCHED;
            PG8_LDB(B1, 0, 1); PG8_STAGE(PG8_SB(0, 0), b2, voffB);
            PG8_BAR; PG8_WAIT_L(0); PG8_MMA(0, 1, At, B1); PG8_BAR;
            PG8_LDA(At, 0, 1); PG8_STAGE(PG8_SA(0, 0), a2, voffA);
            PG8_BAR; PG8_WAIT_L(0); PG8_MMA(1, 0, At, B0); PG8_BAR; PG8_SCHED;
            PG8_STAGE(PG8_SB(0, 1), b2 + hstep, voffB);
            PG8_WAIT_V(6); PG8_BAR; PG8_MMA(1, 1, At, B1); PG8_BAR;
            PG8_LDB(B0, 1, 0); PG8_SCHED; PG8_LDA(At, 1, 0); PG8_STAGE(PG8_SA(0, 1), a2 + hstep, voffA);
            PG8_WAIT_L(8); PG8_BAR; PG8_WAIT_L(0); PG8_MMA(0, 0, At, B0); PG8_BAR; PG8_SCHED;
            PG8_LDB(B1, 1, 1); PG8_STAGE(PG8_SB(1, 0), b3, voffB);
            PG8_BAR; PG8_WAIT_L(0); PG8_MMA(0, 1, At, B1); PG8_BAR;
            PG8_LDA(At, 1, 1); PG8_STAGE(PG8_SA(1, 0), a3, voffA);
            PG8_BAR; PG8_WAIT_L(0); PG8_MMA(1, 0, At, B0); PG8_BAR; PG8_SCHED;
            PG8_STAGE(PG8_SB(1, 1), b3 + hstep, voffB);
            PG8_WAIT_V(6); PG8_BAR; PG8_MMA(1, 1, At, B1); PG8_BAR;
            }
        }
        if constexpr (ALIGN_EPI) { if (wr == 0) PG8_BAR; }
        if constexpr (!Epi::AFTER_DRAIN) { E(acc, cur, wr, wc, fr, fq); S.done(cur); }
        if (!has_next) break;
#pragma unroll
        for (int a = 0; a < 2; ++a)
#pragma unroll
            for (int b = 0; b < 2; ++b)
#pragma unroll
                for (int m = 0; m < 4; ++m)
#pragma unroll
                    for (int n = 0; n < 2; ++n) acc[a][b][m][n] = (f32x4){0.f, 0.f, 0.f, 0.f};
        cur = nxt; cA = nA; cB = nB; ++ui;
        if constexpr (ALIGN_EPI) { if (wr == 1) PG8_BAR; }
    }
    PG8_WAIT_V(0);
    if constexpr (!ALIGN_EPI) { if (wr == 0) PG8_BAR; }
    PG8_BAR;
    if constexpr (Epi::AFTER_DRAIN) { E.fused(acc, cur, wr, wc, fr, fq, lds, wid, lane); S.done(cur); }
#undef PG8_SA
#undef PG8_SB
#undef PG8_STAGE
#undef PG8_LDA
#undef PG8_LDB
#undef PG8_MMA
#undef PG8_WAIT_V
#undef PG8_WAIT_L
#undef PG8_BAR
#undef PG8_SCHED
}
}
#define GAS __attribute__((address_space(1)))
#define LAS __attribute__((address_space(3)))
typedef unsigned short bf16;
typedef unsigned v4u __attribute__((ext_vector_type(4)));
typedef float f32x4 __attribute__((ext_vector_type(4)));
typedef short bf16x8 __attribute__((ext_vector_type(8)));
typedef GAS unsigned gu32;
typedef GAS unsigned long long gu64;
#define RLX_AGENT __ATOMIC_RELAXED, __HIP_MEMORY_SCOPE_AGENT
#define LDS_WAIT() asm volatile("s_waitcnt lgkmcnt(0)" ::: "memory")
#define VM_WAIT() asm volatile("s_waitcnt vmcnt(0)" ::: "memory")
__device__ __forceinline__ unsigned long long rt() { return __builtin_amdgcn_s_memrealtime(); }
__device__ __forceinline__ unsigned f2bf(float f) { unsigned u = __builtin_bit_cast(unsigned, f); return (u + 0x7fffu + ((u >> 16) & 1u)) >> 16; }
__device__ __forceinline__ unsigned pk2(float lo, float hi) { return f2bf(lo) | (f2bf(hi) << 16); }

#define XB_TMO      128
#define XB_XCNT(j)  (256  + 64 * (j))
#define XB_XSUB(j)  (1280 + 64 * (j))
#define XB_XGEN(j)  (2304 + 64 * (j))
#define XB_TOP      3328
#define XB_TOPGEN   3392
#define XCD_BAR_WORDS 3456
#define XB_SPIN_CAP (1u << 18)

__device__ __forceinline__ unsigned xb_ld(unsigned* p)              { return __hip_atomic_load(p, __ATOMIC_RELAXED, __HIP_MEMORY_SCOPE_AGENT); }
__device__ __forceinline__ unsigned xb_add(unsigned* p, unsigned v) { return __hip_atomic_fetch_add(p, v, __ATOMIC_RELAXED, __HIP_MEMORY_SCOPE_AGENT); }
__device__ __forceinline__ unsigned xb_xcc_id() { return (unsigned)__builtin_amdgcn_s_getreg((3 << 11) | 20) & 0xFu; }
#define XB_SPIN(cond, bar) do { unsigned _sp = 0; while (cond) { __builtin_amdgcn_s_sleep(1); \
    if ((++_sp & 255u) == 0u) { if (xb_ld(&(bar)[XB_TMO])) break; if (_sp > XB_SPIN_CAP) { atomicAdd(&(bar)[XB_TMO], 1u); break; } } } } while (0)

struct XcdBarrier {
    unsigned* bar; unsigned x;
    volatile LAS unsigned* st;
};

__device__ __forceinline__ XcdBarrier xcd_barrier_post(unsigned* bar, volatile LAS unsigned* st) {
    XcdBarrier b; b.bar = bar; b.x = xb_xcc_id(); b.st = st;
    if (threadIdx.x == 0) (void)xb_add(&bar[XB_XCNT(b.x)], 1u);
    return b;
}
__device__ __forceinline__ void xcd_barrier_complete(unsigned* bar, unsigned x, unsigned& nloc, unsigned& nx) {
    const unsigned G = gridDim.x * gridDim.y * gridDim.z;
    unsigned sum, cnt, mine, sp = 0u;
    for (;;) {
        sum = 0u; cnt = 0u; mine = 0u;
#pragma unroll
        for (unsigned j = 0; j < 16; ++j) { const unsigned c = xb_ld(&bar[XB_XCNT(j)]); sum += c; cnt += (c > 0u) ? 1u : 0u; mine = (j == x) ? c : mine; }
        if (sum == G) break;
        __builtin_amdgcn_s_sleep(1);
        if ((++sp & 255u) == 0u) { if (xb_ld(&bar[XB_TMO])) break; if (sp > XB_SPIN_CAP) { atomicAdd(&bar[XB_TMO], 1u); break; } }
    }
    nloc = mine > 0u ? mine : 1u; nx = cnt > 0u ? cnt : 1u;
}

__device__ __forceinline__ void xcd_barrier(const XcdBarrier& b) {
    asm volatile("s_waitcnt vmcnt(0)" ::: "memory");
    __syncthreads();
    if (threadIdx.x == 0) {
        unsigned* bar = b.bar;
        __builtin_amdgcn_s_waitcnt(0);
        unsigned nloc = b.st[0], nx = b.st[1];
        if (nloc == 0u) { xcd_barrier_complete(bar, b.x, nloc, nx); b.st[0] = nloc; b.st[1] = nx; }
        const unsigned old = xb_add(&bar[XB_XSUB(b.x)], 1u);
        const unsigned gen = old / nloc;
        if (old + 1u == (gen + 1u) * nloc) {
            __builtin_amdgcn_fence(__ATOMIC_RELEASE, "agent");
            asm volatile("s_waitcnt vmcnt(0)" ::: "memory");
            const unsigned og = xb_add(&bar[XB_TOP], 1u);
            const unsigned tg = og / nx;
            if (og + 1u == (tg + 1u) * nx) xb_add(&bar[XB_TOPGEN], 1u);
            else XB_SPIN(xb_ld(&bar[XB_TOPGEN]) == tg, bar);
            __builtin_amdgcn_fence(__ATOMIC_ACQUIRE, "agent");
            xb_add(&bar[XB_XGEN(b.x)], 1u);
            asm volatile("s_waitcnt vmcnt(0)" ::: "memory");
        } else {
            XB_SPIN(xb_ld(&bar[XB_XGEN(b.x)]) == gen, bar);
            __builtin_amdgcn_fence(__ATOMIC_ACQUIRE, "agent");
            asm volatile("s_waitcnt vmcnt(0)" ::: "memory");
        }
    }
    __syncthreads();
}

typedef float f32x16 __attribute__((ext_vector_type(16)));
typedef short s16x4 __attribute__((ext_vector_type(4)));
typedef short v4i16_t __attribute__((ext_vector_type(4)));
typedef unsigned u32x2 __attribute__((ext_vector_type(2)));
typedef float f32x2_t __attribute__((ext_vector_type(2)));
typedef __bf16 bf16x2_t __attribute__((ext_vector_type(2)));

constexpr int NTOK = 32768, SEQ = 4096, DMODEL = 1024, DFF = 4096;
constexpr int LDP = 4864;
constexpr int NPROJ = 5120;
constexpr int INW = 4888;
constexpr float NORM_EPS = 1e-6f;
constexpr size_t MiB = 1u << 20;
constexpr size_t WS_CTL = 0, CTL_ZERO_BYTES = 1 * MiB;
constexpr size_t WS_WIN = 2 * MiB, WS_WUPN = 12 * MiB, WS_WUPM = 13 * MiB, WS_WOUT = 14 * MiB, WS_WFF1 = 16 * MiB, WS_WFF2 = 24 * MiB;
constexpr size_t WS_WC1K = 32 * MiB, WS_WC1V = 32 * MiB + 256 * 1024, WS_ROPE = 32 * MiB + 512 * 1024;
constexpr size_t WS_KC = 33 * MiB, WS_VC = 33 * MiB + 512 * 1024, WS_KMH = 34 * MiB, WS_KML = 34 * MiB + 256 * 1024;
constexpr size_t WS_SSQ = 460 * MiB;
constexpr size_t WS_GN = 35 * MiB;
constexpr size_t WS_QR = 40 * MiB;
constexpr size_t WS_HN = 72 * MiB;
constexpr size_t WS_YN = 72 * MiB, WS_YM = 104 * MiB;
constexpr size_t WS_MIX = 136 * MiB;
constexpr size_t WS_P = 200 * MiB;
constexpr size_t WS_U = 200 * MiB;
constexpr size_t WS_END = 504 * MiB;
constexpr int CW_BAR = 4096;

constexpr int LDS_BYTES = 147456, MISC_OFF = LDS_BYTES - 2048;
constexpr int NWAVES = 8;

__device__ __forceinline__ float bflo(unsigned w) { return __uint_as_float(w << 16); }
__device__ __forceinline__ float bfhi(unsigned w) { return __uint_as_float(w & 0xffff0000u); }
__device__ __forceinline__ unsigned cvtpk_s(float lo, float hi) { f32x2_t v = {lo, hi}; bf16x2_t b = __builtin_convertvector(v, bf16x2_t); return __builtin_bit_cast(unsigned, b); }
__device__ __forceinline__ float wave_sum(float v) {
#pragma unroll
    for (int o = 1; o < 64; o <<= 1) v += __shfl_xor(v, o);
    return v;
}
constexpr float QSCALE = 0.125f * 1.4426950408889634f;
__device__ __forceinline__ float sigmoidf_(float v) { return 1.0f / (1.0f + __expf(-v)); }

struct EpiProj {
    static constexpr bool PERM = true, AFTER_DRAIN = false;
    bf16* P; bf16* QR; float* GN; const float* rope;
    __device__ __forceinline__ void operator()(const f32x4 (&acc)[2][2][4][2], const pg8::Unit& u, int wr, int wc, int fr, int fq) const {
        const int pn = u.pn; const int row0 = u.pm * 256 + wr * 64 + fr;
        const bool ropelane = ((wc & 1) == 0) && (fq < 2);
#pragma unroll
        for (int bj = 0; bj < 2; ++bj) {
            int mode;
            if (pn < 2) mode = 2; else if (pn == 2) mode = 0; else if (pn <= 4) mode = (bj == 0) ? 1 : 0; else if (pn <= 8) mode = 1; else if (pn <= 10) mode = 0; else if (pn <= 18) mode = 3; else mode = 4;
            const int col = pn * 256 + bj * 128 + wc * 32 + 8 * fq;
#pragma unroll
            for (int ai = 0; ai < 2; ++ai)
#pragma unroll
                for (int m = 0; m < 4; ++m) {
                    const int row = row0 + ai * 128 + m * 16;
                    const f32x4 a0 = acc[ai][bj][m][0], a1 = acc[ai][bj][m][1];
                    float v[8] = {a0[0], a0[1], a0[2], a0[3], a1[0], a1[1], a1[2], a1[3]};
                    if (mode == 1 || mode == 2) {
                        float pv[8], o[8];
#pragma unroll
                        for (int i = 0; i < 8; ++i) { pv[i] = __shfl_xor(v[i], 16); o[i] = v[i]; }
                        if (ropelane) {
                            const float* cs = rope + (size_t)(row & (SEQ - 1)) * 16;
                            const f32x4 c0 = *(const f32x4*)cs, c1 = *(const f32x4*)(cs + 4), s0 = *(const f32x4*)(cs + 8), s1 = *(const f32x4*)(cs + 12);
                            const float c[8] = {c0[0], c0[1], c0[2], c0[3], c1[0], c1[1], c1[2], c1[3]}, s[8] = {s0[0], s0[1], s0[2], s0[3], s1[0], s1[1], s1[2], s1[3]};
#pragma unroll
                            for (int i = 0; i < 8; ++i) o[i] = (fq == 0) ? (v[i] * c[i] - pv[i] * s[i]) : (pv[i] * s[i] + v[i] * c[i]);
                        }
                        if (mode == 2 || pn == 5 || pn == 6) {
#pragma unroll
                            for (int i = 0; i < 8; ++i) o[i] *= QSCALE;
                        }
                        if (mode == 2) {
                            v4u w; w.x = cvtpk_s(v[0], v[1]); w.y = cvtpk_s(v[2], v[3]); w.z = cvtpk_s(v[4], v[5]); w.w = cvtpk_s(v[6], v[7]);
                            *(v4u*)(P + (size_t)row * LDP + col) = w;
                            v4u w2; w2.x = cvtpk_s(o[0], o[1]); w2.y = cvtpk_s(o[2], o[3]); w2.z = cvtpk_s(o[4], o[5]); w2.w = cvtpk_s(o[6], o[7]);
                            *(v4u*)(QR + (size_t)row * 512 + col) = w2;
                        } else {
                            v4u w2; w2.x = cvtpk_s(o[0], o[1]); w2.y = cvtpk_s(o[2], o[3]); w2.z = cvtpk_s(o[4], o[5]); w2.w = cvtpk_s(o[6], o[7]);
                            *(v4u*)(P + (size_t)row * LDP + col) = w2;
                        }
                    } else if (mode == 0) {
                        v4u w; w.x = cvtpk_s(v[0], v[1]); w.y = cvtpk_s(v[2], v[3]); w.z = cvtpk_s(v[4], v[5]); w.w = cvtpk_s(v[6], v[7]);
                        *(v4u*)(P + (size_t)row * LDP + col) = w;
                    } else if (mode == 3) {
#pragma unroll
                        for (int i = 0; i < 8; ++i) v[i] = sigmoidf_(v[i]);
                        v4u w; w.x = cvtpk_s(v[0], v[1]); w.y = cvtpk_s(v[2], v[3]); w.z = cvtpk_s(v[4], v[5]); w.w = cvtpk_s(v[6], v[7]);
                        *(v4u*)(P + (size_t)row * LDP + col) = w;
                    } else {
                        if (bj == 0 && wc == 0 && fq < 3) {
                            float* gp = GN + (size_t)row * 32 + 8 * fq;
                            *(f32x4*)gp = (f32x4){sigmoidf_(v[0]), sigmoidf_(v[1]), sigmoidf_(v[2]), sigmoidf_(v[3])};
                            *(f32x4*)(gp + 4) = (f32x4){sigmoidf_(v[4]), sigmoidf_(v[5]), sigmoidf_(v[6]), sigmoidf_(v[7])};
                        }
                    }
                }
        }
    }
};
struct EpiMerge {
    static constexpr bool PERM = true, AFTER_DRAIN = false;
    const bf16* P; bf16* MIX;
    __device__ __forceinline__ void operator()(const f32x4 (&acc)[2][2][4][2], const pg8::Unit& u, int wr, int wc, int fr, int fq) const {
        const int row0 = u.pm * 256 + wr * 64 + fr; const int src = u.src;
#pragma unroll
        for (int ai = 0; ai < 2; ++ai)
#pragma unroll
            for (int m = 0; m < 4; ++m) {
                const int row = row0 + ai * 128 + m * 16;
#pragma unroll
                for (int bj = 0; bj < 2; ++bj) {
                    const int col = u.pn * 256 + bj * 128 + wc * 32 + 8 * fq;
                    const v4u gw = *(const v4u*)(P + (size_t)row * LDP + 2816 + src * 1024 + col);
                    const f32x4 a0 = acc[ai][bj][m][0], a1 = acc[ai][bj][m][1];
                    float r[8] = {a0[0] * bflo(gw.x), a0[1] * bfhi(gw.x), a0[2] * bflo(gw.y), a0[3] * bfhi(gw.y), a1[0] * bflo(gw.z), a1[1] * bfhi(gw.z), a1[2] * bflo(gw.w), a1[3] * bfhi(gw.w)};
                    bf16* mp = MIX + (size_t)row * DMODEL + col;
                    if (src) { const v4u pw = *(const v4u*)mp;
                        r[0] += bflo(pw.x); r[1] += bfhi(pw.x); r[2] += bflo(pw.y); r[3] += bfhi(pw.y); r[4] += bflo(pw.z); r[5] += bfhi(pw.z); r[6] += bflo(pw.w); r[7] += bfhi(pw.w); }
                    v4u w; w.x = cvtpk_s(r[0], r[1]); w.y = cvtpk_s(r[2], r[3]); w.z = cvtpk_s(r[4], r[5]); w.w = cvtpk_s(r[6], r[7]);
                    *(v4u*)mp = w;
                }
            }
    }
};
struct EpiRes {
    static constexpr bool PERM = false, AFTER_DRAIN = false;
    const float* base; float* out;
    __device__ __forceinline__ void operator()(const f32x4 (&acc)[2][2][4][2], const pg8::Unit& u, int wr, int wc, int fr, int fq) const {
        const int row0 = u.pm * 256 + wr * 64 + fr; const int col0 = u.pn * 256 + wc * 32 + 4 * fq;
#pragma unroll
        for (int ai = 0; ai < 2; ++ai)
#pragma unroll
            for (int m = 0; m < 4; ++m) {
                const size_t off = (size_t)(row0 + ai * 128 + m * 16) * DMODEL + col0;
#pragma unroll
                for (int bj = 0; bj < 2; ++bj)
#pragma unroll
                    for (int n = 0; n < 2; ++n) { const f32x4 bs = *(const f32x4*)(base + off + bj * 128 + n * 16); *(f32x4*)(out + off + bj * 128 + n * 16) = bs + acc[ai][bj][m][n]; }
            }
    }
};
struct EpiResNorm {
    static constexpr bool PERM = false, AFTER_DRAIN = false;
    const float* base; float* out; bf16* XB; const float* g; float* SSQ;
    __device__ __forceinline__ void operator()(const f32x4 (&acc)[2][2][4][2], const pg8::Unit& u, int wr, int wc, int fr, int fq) const {
        const int row0 = u.pm * 256 + wr * 64 + fr; const int col0 = u.pn * 256 + wc * 32 + 4 * fq;
        f32x4 gv[2][2];
#pragma unroll
        for (int bj = 0; bj < 2; ++bj)
#pragma unroll
            for (int n = 0; n < 2; ++n) gv[bj][n] = *(const f32x4*)(g + col0 + bj * 128 + n * 16);
#pragma unroll
        for (int ai = 0; ai < 2; ++ai)
#pragma unroll
            for (int m = 0; m < 4; ++m) {
                const int row = row0 + ai * 128 + m * 16; const size_t off = (size_t)row * DMODEL + col0; float ss = 0.f;
#pragma unroll
                for (int bj = 0; bj < 2; ++bj)
#pragma unroll
                    for (int n = 0; n < 2; ++n) { const f32x4 v = *(const f32x4*)(base + off + bj * 128 + n * 16) + acc[ai][bj][m][n]; *(f32x4*)(out + off + bj * 128 + n * 16) = v;
                        ss += (v.x * v.x + v.y * v.y) + (v.z * v.z + v.w * v.w);
                        const f32x4 h = v * gv[bj][n]; *(u32x2*)(XB + off + bj * 128 + n * 16) = (u32x2){cvtpk_s(h.x, h.y), cvtpk_s(h.z, h.w)}; }
                ss += __shfl_xor(ss, 16); ss += __shfl_xor(ss, 32);
                if (fq == 0) SSQ[(size_t)row * 16 + u.pn * 4 + wc] = ss;
            }
    }
};
struct EpiRelu2 {
    static constexpr bool PERM = true, AFTER_DRAIN = false;
    bf16* U; const float* SSQ;
    __device__ __forceinline__ void operator()(const f32x4 (&acc)[2][2][4][2], const pg8::Unit& u, int wr, int wc, int fr, int fq) const {
        const int row0 = u.pm * 256 + wr * 64 + fr; const int col0 = u.pn * 256 + wc * 32 + 8 * fq;
#pragma unroll
        for (int ai = 0; ai < 2; ++ai)
#pragma unroll
            for (int m = 0; m < 4; ++m) {
                bf16* rp = U + (size_t)(row0 + ai * 128 + m * 16) * DFF + col0;
                const float* sp = SSQ + (size_t)(row0 + ai * 128 + m * 16) * 16;
                const f32x4 s0 = *(const f32x4*)sp, s1 = *(const f32x4*)(sp + 4), s2 = *(const f32x4*)(sp + 8), s3 = *(const f32x4*)(sp + 12);
                const float sst = ((((s0.x + s0.y) + (s0.z + s0.w)) + ((s1.x + s1.y) + (s1.z + s1.w))) + (((s2.x + s2.y) + (s2.z + s2.w)) + ((s3.x + s3.y) + (s3.z + s3.w))));
                const float r2 = 1.0f / (sst * (1.0f / DMODEL) + NORM_EPS);
#pragma unroll
                for (int bj = 0; bj < 2; ++bj) {
                    f32x4 a0 = acc[ai][bj][m][0], a1 = acc[ai][bj][m][1];
#pragma unroll
                    for (int i = 0; i < 4; ++i) { const float x = fmaxf(a0[i], 0.f), y = fmaxf(a1[i], 0.f); a0[i] = x * x * r2; a1[i] = y * y * r2; }
                    v4u w; w.x = cvtpk_s(a0[0], a0[1]); w.y = cvtpk_s(a0[2], a0[3]); w.z = cvtpk_s(a1[0], a1[1]); w.w = cvtpk_s(a1[2], a1[3]);
                    *(v4u*)(rp + bj * 128) = w;
                }
            }
    }
};

__device__ __forceinline__ int win_src_col(int n) { return n < 1280 ? n : (n < 4864 ? n + 24 : (n < INW ? n - 3584 : -1)); }
__device__ __forceinline__ void transpose_item(const float* W, int K, int N, int Nd, bf16* WT, LAS float* scr, int item, int lane, bool remap) {
    const int nblk = Nd / 32, kb = item / nblk, nb = item % nblk, k0 = 64 * kb, n0 = 32 * nb;
    int sc = n0 + (lane & 31); if (remap) sc = win_src_col(sc);
#pragma unroll 8
    for (int i = 0; i < 32; ++i) { const int kk = 2 * i + (lane >> 5); scr[kk * 33 + (lane & 31)] = sc >= 0 ? W[(size_t)(k0 + kk) * N + sc] : 0.f; }
    LDS_WAIT(); asm volatile("" ::: "memory");
    const int c = lane & 7;
#pragma unroll
    for (int j = 0; j < 4; ++j) { const int n = (lane >> 3) + 8 * j; const LAS float* s = scr + (8 * c) * 33 + n;
        v4u o; o.x = pk2(s[0 * 33], s[1 * 33]); o.y = pk2(s[2 * 33], s[3 * 33]); o.z = pk2(s[4 * 33], s[5 * 33]); o.w = pk2(s[6 * 33], s[7 * 33]);
        *(GAS v4u*)(WT + (size_t)(n0 + n) * K + k0 + 8 * c) = o; }
    LDS_WAIT(); asm volatile("" ::: "memory");
}
template <bool OUTF32> __device__ __forceinline__ void rms_row(const float* xrow, const float* g, void* orow, int lane) {
    const f32x4* xr = (const f32x4*)xrow + lane; const f32x4* gr = (const f32x4*)g + lane;
    f32x4 v[4]; float s = 0.f;
#pragma unroll
    for (int j = 0; j < 4; ++j) { v[j] = xr[64 * j]; s += (v[j].x * v[j].x + v[j].y * v[j].y) + (v[j].z * v[j].z + v[j].w * v[j].w); }
    const float rstd = 1.0f / sqrtf(wave_sum(s) * (1.0f / DMODEL) + NORM_EPS);
#pragma unroll
    for (int j = 0; j < 4; ++j) { const f32x4 gg = gr[64 * j]; const f32x4 o = v[j] * rstd * gg;
        if (OUTF32) ((f32x4*)orow + lane)[64 * j] = o;
        else ((u32x2*)orow + lane)[64 * j] = (u32x2){cvtpk_s(o.x, o.y), cvtpk_s(o.z, o.w)}; }
}

namespace att {
constexpr float C2 = 0.125f * 1.4426950408889634f;
__device__ __forceinline__ int crow(int r, int hi) { return (r & 3) + 8 * (r >> 2) + 4 * hi; }
__device__ __forceinline__ float pmax(float v) { auto rr = __builtin_amdgcn_permlane32_swap(__float_as_uint(v), __float_as_uint(v), false, false); return fmaxf(__uint_as_float(rr[0]), __uint_as_float(rr[1])); }
__device__ __forceinline__ float pget(float v, int hi) { auto rr = __builtin_amdgcn_permlane32_swap(__float_as_uint(v), __float_as_uint(v), false, false); return __uint_as_float(hi ? rr[0] : rr[1]); }
__device__ __forceinline__ float psum(float v) { auto rr = __builtin_amdgcn_permlane32_swap(__float_as_uint(v), __float_as_uint(v), false, false); return __uint_as_float(rr[0]) + __uint_as_float(rr[1]); }
__device__ __forceinline__ void stage_kv(LAS unsigned char* lds, int koff, int voff, const bf16* Kt, const bf16* Vt, int pitch, int wid, int lane) {
    const int r = 8 * wid + (lane >> 3), cs = lane & 7;
    const unsigned ko = (unsigned)(r * pitch + ((cs ^ ((r >> 1) & 7)) << 3)), vo = (unsigned)(r * pitch + ((cs ^ (((r >> 1) & 1) << 2)) << 3));
    const bf16* ks = Kt + ko; const bf16* vs = Vt + vo;
    __builtin_amdgcn_global_load_lds((const unsigned*)ks, (LAS unsigned*)(lds + koff + wid * 1024), 16, 0, 0);
    __builtin_amdgcn_global_load_lds((const unsigned*)vs, (LAS unsigned*)(lds + voff + wid * 1024), 16, 0, 0);
}
__device__ __forceinline__ void qkt(f32x16& p0, f32x16& p1, LAS const unsigned char* kslot, const bf16x8 (&q)[4], const f32x16& init, int r32, int hi) {
    LAS const unsigned char* kb = kslot + r32 * 128; const int sw = (r32 >> 1) & 7;
    bf16x8 kf[8];
#pragma unroll
    for (int d0 = 0; d0 < 4; ++d0) { const int x = ((2 * d0 + hi) ^ sw) << 4; kf[2 * d0] = *(LAS const bf16x8*)(kb + x); kf[2 * d0 + 1] = *(LAS const bf16x8*)(kb + x + 4096); }
    __builtin_amdgcn_sched_barrier(0);
    p0 = __builtin_amdgcn_mfma_f32_32x32x16_bf16(kf[0], q[0], init, 0, 0, 0); p1 = __builtin_amdgcn_mfma_f32_32x32x16_bf16(kf[1], q[0], init, 0, 0, 0);
#pragma unroll
    for (int d0 = 1; d0 < 4; ++d0) { p0 = __builtin_amdgcn_mfma_f32_32x32x16_bf16(kf[2 * d0], q[d0], p0, 0, 0, 0); p1 = __builtin_amdgcn_mfma_f32_32x32x16_bf16(kf[2 * d0 + 1], q[d0], p1, 0, 0, 0); }
    __builtin_amdgcn_sched_barrier(0);
}
__device__ __forceinline__ s16x4 vtr(LAS const unsigned char* p) { return __builtin_bit_cast(s16x4, __builtin_amdgcn_ds_read_tr16_b64_v4i16((LAS v4i16_t*)p)); }
__device__ __forceinline__ int vpo_of(int lane) { const int hi = lane >> 5, q = (lane & 15) >> 2, p = lane & 3, dsub = (lane >> 4) & 1; return ((4 * hi + q) * 128 + dsub * 32 + p * 8) | (((q >> 1) & 1) << 30); }
__device__ __forceinline__ void pv(f32x16 (&o)[2], LAS const unsigned char* vslot, int vpo, const bf16x8 (&pa)[4]) {
    const int vsw = ((vpo >> 30) & 1) * 64;
    LAS const unsigned char* vb = vslot + (vpo & 0xffff);
#pragma unroll
    for (int d0 = 0; d0 < 2; ++d0) {
        LAS const unsigned char* vp = vb + (d0 ? 64 - vsw : vsw);
        s16x4 lo[4], h4[4];
#pragma unroll
        for (int i = 0; i < 4; ++i) { lo[i] = vtr(vp + i * 2048); h4[i] = vtr(vp + i * 2048 + 1024); }
        __builtin_amdgcn_sched_barrier(0);
#pragma unroll
        for (int i = 0; i < 4; ++i) {
            const bf16x8 vf = {lo[i][0], lo[i][1], lo[i][2], lo[i][3], h4[i][0], h4[i][1], h4[i][2], h4[i][3]};
            o[d0] = __builtin_amdgcn_mfma_f32_32x32x16_bf16(vf, pa[i], o[d0], 0, 0, 0);
        }
        __builtin_amdgcn_sched_barrier(0);
    }
}
__device__ __forceinline__ void pack_p(bf16x8 (&pa)[4], const f32x16& p0, const f32x16& p1) {
    const v4u w0 = {cvtpk_s(p0[0], p0[1]), cvtpk_s(p0[2], p0[3]), cvtpk_s(p0[4], p0[5]), cvtpk_s(p0[6], p0[7])};
    const v4u w1 = {cvtpk_s(p0[8], p0[9]), cvtpk_s(p0[10], p0[11]), cvtpk_s(p0[12], p0[13]), cvtpk_s(p0[14], p0[15])};
    const v4u w2 = {cvtpk_s(p1[0], p1[1]), cvtpk_s(p1[2], p1[3]), cvtpk_s(p1[4], p1[5]), cvtpk_s(p1[6], p1[7])};
    const v4u w3 = {cvtpk_s(p1[8], p1[9]), cvtpk_s(p1[10], p1[11]), cvtpk_s(p1[12], p1[13]), cvtpk_s(p1[14], p1[15])};
    pa[0] = __builtin_bit_cast(bf16x8, w0); pa[1] = __builtin_bit_cast(bf16x8, w1); pa[2] = __builtin_bit_cast(bf16x8, w2); pa[3] = __builtin_bit_cast(bf16x8, w3);
}
__device__ __forceinline__ void mask_gt(f32x16& p0, f32x16& p1, int lim, int hi) {
#pragma unroll
    for (int r = 0; r < 16; ++r) { const int kk = crow(r, hi); if (kk > lim) p0[r] = -INFINITY; if (kk + 32 > lim) p1[r] = -INFINITY; }
}
__device__ __forceinline__ void mask_le(f32x16& p0, f32x16& p1, int lim, int hi) {
#pragma unroll
    for (int r = 0; r < 16; ++r) { const int kk = crow(r, hi); if (kk <= lim) p0[r] = -INFINITY; if (kk + 32 <= lim) p1[r] = -INFINITY; }
}
__device__ __forceinline__ float tile_max(const f32x16& p0, const f32x16& p1) {
    float rm = fmaxf(p0[0], p1[0]);
#pragma unroll
    for (int r = 1; r < 16; ++r) rm = fmaxf(rm, fmaxf(p0[r], p1[r]));
    return rm;
}
__device__ __forceinline__ float max3f(float a, float b, float c) { float r; asm("v_max3_f32 %0, %1, %2, %3" : "=v"(r) : "v"(a), "v"(b), "v"(c)); return r; }
__device__ __forceinline__ float max2f(float a, float b) { float r; asm("v_max_f32_e32 %0, %1, %2" : "=v"(r) : "v"(a), "v"(b)); return r; }
__device__ __forceinline__ float tile_max3(const f32x16& p0, const f32x16& p1) {
    float a = max3f(p0[0], p0[1], p1[0]), b = max3f(p0[2], p0[3], p1[1]); a = max3f(a, p1[2], p1[3]);
#pragma unroll
    for (int r = 4; r < 16; r += 4) { a = max3f(a, p0[r], p0[r + 1]); b = max3f(b, p0[r + 2], p0[r + 3]); a = max3f(a, p1[r], p1[r + 1]); b = max3f(b, p1[r + 2], p1[r + 3]); }
    return max2f(a, b);
}
__device__ __forceinline__ void fin_add(f32x16 (&y)[2], const f32x16 (&o)[2], float l, float gate) {
    const float lt = psum(l); const float sc = lt > 0.f ? gate / lt : 0.f;
    y[0] += o[0] * sc; y[1] += o[1] * sc;
}
__device__ __forceinline__ void store_y(bf16* yrow, const f32x16 (&y)[2], int hi) {
#pragma unroll
    for (int d0 = 0; d0 < 2; ++d0)
#pragma unroll
        for (int rg = 0; rg < 4; ++rg) {
            const u32x2 w = {cvtpk_s(y[d0][4 * rg], y[d0][4 * rg + 1]), cvtpk_s(y[d0][4 * rg + 2], y[d0][4 * rg + 3])};
            *(u32x2*)(yrow + 32 * d0 + 8 * rg + 4 * hi) = w;
        }
}
__device__ __forceinline__ int next_set(unsigned long long um, int from) { if (from >= 64) return 64; const unsigned long long x = um >> from; return x ? from + __builtin_ctzll(x) : 64; }


constexpr float THR = 8.0f;
#ifndef MK_AHEAD
#define MK_AHEAD 2
#endif
constexpr int AHEAD = MK_AHEAD, NSLOT = (MK_AHEAD == 2) ? 4 : 8;
__device__ __forceinline__ void glds16(const void* gsrc, unsigned lds_dst) { unsigned keep;
    asm volatile("s_mov_b32 %0, m0\n\ts_mov_b32 m0, %2\n\ts_nop 0\n\tglobal_load_lds_dwordx4 %1, off\n\ts_mov_b32 m0, %0" : "=&s"(keep) : "v"(gsrc), "s"(lds_dst) : "memory"); }
__device__ __forceinline__ void stage_kv_asm(unsigned ring_addr, int koff, int voff, const bf16* Kt, const bf16* Vt, int pitch, int wid, int lane) {
    const int r = 8 * wid + (lane >> 3), cs = lane & 7;
    const unsigned ko = (unsigned)(r * pitch + ((cs ^ ((r >> 1) & 7)) << 3)), vo = (unsigned)(r * pitch + ((cs ^ (((r >> 1) & 1) << 2)) << 3));
    glds16(Kt + ko, (unsigned)__builtin_amdgcn_readfirstlane((int)(ring_addr + koff + wid * 1024)));
    glds16(Vt + vo, (unsigned)__builtin_amdgcn_readfirstlane((int)(ring_addr + voff + wid * 1024)));
}
#define ATT_BAR() do { __builtin_amdgcn_sched_barrier(0); asm volatile("s_waitcnt lgkmcnt(0)" ::: "memory"); if (!(DBG & 8)) __builtin_amdgcn_s_barrier(); asm volatile("" ::: "memory"); __builtin_amdgcn_sched_barrier(0); } while (0)
#define ATT_WAIT_BAR(more) do { __builtin_amdgcn_sched_barrier(0); if (more) asm volatile("s_waitcnt vmcnt(2) lgkmcnt(0)" ::: "memory"); else asm volatile("s_waitcnt vmcnt(0) lgkmcnt(0)" ::: "memory"); __builtin_amdgcn_s_barrier(); asm volatile("" ::: "memory"); __builtin_amdgcn_sched_barrier(0); } while (0)
#ifndef MK_TPROBE
#define MK_TPROBE 0
#endif
#if MK_TPROBE == 6
#define TP_NOW() __builtin_amdgcn_s_memrealtime()
#else
#define TP_NOW() __builtin_amdgcn_s_memtime()
#endif
#define TP_BEGIN(seg) do { if (MK_TPROBE && TPON && (MK_TPROBE == (seg) || ((seg) == 5 && MK_TPROBE == 6))) { __builtin_amdgcn_sched_barrier(0); tp0_ = TP_NOW(); __builtin_amdgcn_sched_barrier(0); } } while (0)
#define TP_END(seg) do { if (MK_TPROBE && TPON && (MK_TPROBE == (seg) || ((seg) == 5 && MK_TPROBE == 6))) { __builtin_amdgcn_sched_barrier(0); tpacc_ += TP_NOW() - tp0_; __builtin_amdgcn_sched_barrier(0); } } while (0)
constexpr unsigned TT_ALWAYS = 1u << 12, TT_CAUSAL = 1u << 13, TT_LOWER = 1u << 16;
template <bool HAS_SEL, int DBG = 0, bool TPON = false> __device__ __forceinline__ void run_tiles(LAS unsigned char* ring, LAS const unsigned* tab, int n, const bf16* Kb, const bf16* Vb, bf16x8 (&q)[4],
                                                                      f32x16 (&o)[2], float& l, unsigned long long mymask, int tqbase, int wid, int lane, int r32, int hi, int vpo) {
    asm volatile("" : "+v"(q[0]), "+v"(q[1]), "+v"(q[2]), "+v"(q[3]));
    const bool hb = wid >= 4;
    const unsigned ring_addr = (unsigned)(size_t)ring;
    const int tq = tqbase + r32;
    float mhat = 0.f; bool started = false; l = 0.f;
    f32x16 negm = {0.f, 0.f, 0.f, 0.f, 0.f, 0.f, 0.f, 0.f, 0.f, 0.f, 0.f, 0.f, 0.f, 0.f, 0.f, 0.f};
    f32x16 p0 = negm, p1 = negm; bf16x8 pa[4]; if (DBG) { pa[0] = (bf16x8){0,0,0,0,0,0,0,0}; pa[1] = pa[0]; pa[2] = pa[0]; pa[3] = pa[0]; }
#define ATT_ISSUE(tt) do { const int ti_ = (tt) < n ? (tt) : n - 1; const unsigned dd_ = (unsigned)__builtin_amdgcn_readfirstlane((int)tab[ti_]); const size_t k0_ = (size_t)(64 * (dd_ & 63u)); \
        const int so_ = ((tt) & 3) * 16384; stage_kv_asm(ring_addr, so_, so_ + 8192, Kb + k0_ * LDP, Vb + k0_ * LDP, LDP, wid, lane); } while (0)
#define ATT_WAIT_BAR2() do { __builtin_amdgcn_sched_barrier(0); if (DBG & 4) asm volatile("s_waitcnt lgkmcnt(0)" ::: "memory"); else asm volatile("s_waitcnt vmcnt(2) lgkmcnt(0)" ::: "memory"); \
        if (!(DBG & 8)) __builtin_amdgcn_s_barrier(); asm volatile("" ::: "memory"); __builtin_amdgcn_sched_barrier(0); } while (0)
    ATT_ISSUE(0); ATT_ISSUE(1);
    ATT_WAIT_BAR2();
    if (hb) ATT_BAR();
    bool act_prev = false;
    unsigned d = (unsigned)__builtin_amdgcn_readfirstlane((int)tab[0]);
    unsigned dI = (unsigned)__builtin_amdgcn_readfirstlane((int)tab[2 < n ? 2 : n - 1]);
    unsigned long long tp0_ = 0ull, tpacc_ = 0ull;
    LAS const unsigned char* const kb0 = ring + r32 * 128; const int ksw = (r32 >> 1) & 7;
    const int vsw = ((vpo >> 30) & 1) * 64; LAS const unsigned char* const vb0 = ring + 8192 + (vpo & 0xffff);
#define ATT_EXP_HALF(P, W0, W1) do { float s_ = 0.f; _Pragma("unroll") for (int r = 0; r < 16; ++r) { P[r] = __builtin_amdgcn_exp2f(P[r]); s_ += P[r]; } l += s_; \
        { const v4u w0_ = {cvtpk_s(P[0], P[1]), cvtpk_s(P[2], P[3]), cvtpk_s(P[4], P[5]), cvtpk_s(P[6], P[7])}; const v4u w1_ = {cvtpk_s(P[8], P[9]), cvtpk_s(P[10], P[11]), cvtpk_s(P[12], P[13]), cvtpk_s(P[14], P[15])}; \
          pa[W0] = __builtin_bit_cast(bf16x8, w0_); pa[W1] = __builtin_bit_cast(bf16x8, w1_); } } while (0)
#define ATT_PV_HALF(slotbase, d0) do { LAS const unsigned char* vp_ = vb0 + (slotbase) + ((d0) ? 64 - vsw : vsw); s16x4 lo_[4], h4_[4]; \
        _Pragma("unroll") for (int i = 0; i < 4; ++i) { lo_[i] = vtr(vp_ + i * 2048); h4_[i] = vtr(vp_ + i * 2048 + 1024); } \
        __builtin_amdgcn_sched_barrier(0); \
        _Pragma("unroll") for (int i = 0; i < 4; ++i) { const bf16x8 vf_ = {lo_[i][0], lo_[i][1], lo_[i][2], lo_[i][3], h4_[i][0], h4_[i][1], h4_[i][2], h4_[i][3]}; o[d0] = __builtin_amdgcn_mfma_f32_32x32x16_bf16(vf_, pa[i], o[d0], 0, 0, 0); } \
        __builtin_amdgcn_sched_barrier(0); } while (0)
#pragma unroll 1
    for (int t = 0; t < n; ++t) {
        TP_BEGIN(5); TP_BEGIN(1);
        { const size_t k0_ = (size_t)(64 * (dI & 63u)); const int so_ = ((t + 2) & 3) * 16384; stage_kv_asm(ring_addr, so_, so_ + 8192, Kb + k0_ * LDP, Vb + k0_ * LDP, LDP, wid, lane); }
        const unsigned dI_next = tab[t + 3 < n ? t + 3 : n - 1];
        const int coff64 = (int)((d >> 14) & 3u) * 64;
        const bool causal = (d & TT_CAUSAL) != 0u;
        const bool act = !(causal && coff64 > tqbase + 31);
        bf16x8 kf[8];
        if (act && !(DBG & 2)) {
            LAS const unsigned char* kb = kb0 + (t & 3) * 16384;
#pragma unroll
            for (int d0 = 0; d0 < 4; ++d0) { const int x = ((2 * d0 + hi) ^ ksw) << 4; kf[2 * d0] = *(LAS const bf16x8*)(kb + x); kf[2 * d0 + 1] = *(LAS const bf16x8*)(kb + x + 4096); }
        }
        __builtin_amdgcn_sched_barrier(0);
        if (act_prev && !(DBG & 1)) ATT_EXP_HALF(p1, 2, 3);
        __builtin_amdgcn_sched_barrier(0);
        f32x16 q0 = p0, q1 = p1;
        (void)q0; (void)q1;
        if (act) {
            f32x16 cin = negm;
            if (HAS_SEL) { const bool sel = (d & TT_ALWAYS) || ((mymask >> ((d >> 6) & 63u)) & 1ull);
#pragma unroll
                for (int r = 0; r < 16; ++r) cin[r] = sel ? negm[r] : -INFINITY; }
            if (!(DBG & 2)) {
                p0 = __builtin_amdgcn_mfma_f32_32x32x16_bf16(kf[0], q[0], cin, 0, 0, 0); p1 = __builtin_amdgcn_mfma_f32_32x32x16_bf16(kf[1], q[0], cin, 0, 0, 0);
#pragma unroll
                for (int d0 = 1; d0 < 4; ++d0) { p0 = __builtin_amdgcn_mfma_f32_32x32x16_bf16(kf[2 * d0], q[d0], p0, 0, 0, 0); p1 = __builtin_amdgcn_mfma_f32_32x32x16_bf16(kf[2 * d0 + 1], q[d0], p1, 0, 0, 0); }
            } else { p0 = cin; p1 = cin; }
        }
        __builtin_amdgcn_sched_barrier(0);
        if (act_prev && !(DBG & 2)) { ATT_PV_HALF(((t - 1) & 3) * 16384, 0); ATT_PV_HALF(((t - 1) & 3) * 16384, 1); }
        TP_END(1); TP_BEGIN(2);
        ATT_WAIT_BAR2();
        TP_END(2); TP_BEGIN(3);
        if (act && !(DBG & 1)) {
            asm volatile("s_nop 15\n\ts_nop 7" : "+v"(p0), "+v"(p1));
            if (causal && coff64 + 63 > tqbase) mask_gt(p0, p1, tq - coff64, hi);
            if (d & TT_LOWER) mask_le(p0, p1, tq, hi);
            const float rm = pmax(tile_max3(p0, p1));
            const bool move = (rm > -INFINITY) && (!started || rm > THR);
            if (__builtin_expect(__any(move), 0)) {
                asm volatile("" ::: "memory");
                const float dl = move ? rm : 0.f;
                const float f = started ? __builtin_amdgcn_exp2f(-dl) : 1.0f;
                mhat += dl; l *= f; o[0] *= f; o[1] *= f;
#pragma unroll
                for (int r = 0; r < 16; ++r) { p0[r] -= dl; p1[r] -= dl; negm[r] = -mhat; }
                started = started || move;
            }
            asm volatile("" : "+v"(negm));
            ATT_EXP_HALF(p0, 0, 1);
        }
        act_prev = act;
        d = (unsigned)__builtin_amdgcn_readfirstlane((int)tab[t + 1 < n ? t + 1 : n - 1]);
        dI = (unsigned)__builtin_amdgcn_readfirstlane((int)dI_next);
        TP_END(3); TP_BEGIN(4);
        ATT_BAR();
        TP_END(4); TP_END(5);
    }
    if (MK_TPROBE && TPON && wid == 0 && lane == 0) { LAS unsigned long long* ps = (LAS unsigned long long*)(ring + MISC_OFF + 1536); ps[0] += tpacc_; ((LAS unsigned*)(ring + MISC_OFF + 1544))[0] += (unsigned)n; }
    if (act_prev && !(DBG & 1)) ATT_EXP_HALF(p1, 2, 3);
    if (act_prev && !(DBG & 2)) { ATT_PV_HALF(((n - 1) & 3) * 16384, 0); ATT_PV_HALF(((n - 1) & 3) * 16384, 1); }
    __builtin_amdgcn_sched_barrier(0); asm volatile("s_waitcnt vmcnt(0)" ::: "memory");
    ATT_BAR();
    if (!hb) ATT_BAR();
#undef ATT_EXP_HALF
#undef ATT_PV_HALF
#undef ATT_ISSUE
#undef ATT_WAIT_BAR2
}

__device__ __forceinline__ void nsa_item(LAS unsigned char* lds, const bf16* P, const bf16* QR, const float* GN, const bf16* KC, const bf16* VC, bf16* YN,
                                         int b, int g, int tb, int wid, int lane_in, int tid_in) {
    int lane = lane_in, tid = tid_in; asm volatile("" : "+v"(lane), "+v"(tid));
    const int r = wid & 3, ts = wid >> 2, h = 4 * g + r, r32 = lane & 31, hi = lane >> 5;
    const int tq = 32 * ts + r32, t = 64 * tb + tq; const size_t row = (size_t)b * SEQ + t;
    const float g0 = GN[row * 32 + 3 * h], g1 = GN[row * 32 + 3 * h + 1], g2 = GN[row * 32 + 3 * h + 2];
    LAS unsigned* maskw = (LAS unsigned*)(lds + MISC_OFF + 256);
    LAS unsigned* uni = (LAS unsigned*)(lds + MISC_OFF + 768);
    const int vpo = vpo_of(lane);
    const f32x16 zero16 = {0.f, 0.f, 0.f, 0.f, 0.f, 0.f, 0.f, 0.f, 0.f, 0.f, 0.f, 0.f, 0.f, 0.f, 0.f, 0.f};
    f32x16 y[2] = {zero16, zero16};
    if (tid < 128) maskw[tid] = 0u;
    if (tid == 128) { uni[0] = 0u; uni[1] = 0u; }
    __syncthreads();
    const int ntc = ((4 * tb + 2) >> 6) + 1;
    {
        bf16x8 qc[4];
#pragma unroll
        for (int d0 = 0; d0 < 4; ++d0) qc[d0] = *(const bf16x8*)(P + row * LDP + 64 * h + 16 * d0 + 8 * hi);
        const bf16* kcb = KC + (size_t)(b * 2 + g) * 256 * 64; const bf16* vcb = VC + (size_t)(b * 2 + g) * 256 * 64;
#pragma unroll 1
        for (int T = 0; T < ntc; ++T) stage_kv(lds, T * 8192, 32768 + T * 8192, kcb + (size_t)T * 64 * 64, vcb + (size_t)T * 64 * 64, 64, wid, lane);
        __syncthreads();
        const int nlim = t >= 31 ? ((t - 31) >> 4) : -1;
        float m = -1e30f;
#pragma unroll 1
        for (int T = 0; T < ntc; ++T) { f32x16 p0, p1; qkt(p0, p1, lds + T * 8192, qc, zero16, r32, hi); mask_gt(p0, p1, nlim - 64 * T, hi); m = fmaxf(m, tile_max(p0, p1)); }
        m = pmax(m);
        const float mc = -m * C2; float l = 0.f; f32x16 o[2] = {zero16, zero16};
        float carry = 0.f;
        LAS float* Fb = (LAS float*)(lds + 65536) + (wid * 32 + r32) * 65 + hi;
#pragma unroll 1
        for (int T = 0; T < ntc; ++T) {
            f32x16 p0, p1; qkt(p0, p1, lds + T * 8192, qc, zero16, r32, hi); mask_gt(p0, p1, nlim - 64 * T, hi);
            float s = 0.f;
#pragma unroll
            for (int rr = 0; rr < 16; ++rr) { p0[rr] = __builtin_amdgcn_exp2f(fmaf(p0[rr], C2, mc)); p1[rr] = __builtin_amdgcn_exp2f(fmaf(p1[rr], C2, mc)); s += p0[rr] + p1[rr]; }
            l += s;
#pragma unroll
            for (int ph = 0; ph < 2; ++ph)
#pragma unroll
                for (int i = 0; i < 4; ++i) {
                    const float e0 = ph ? p1[4 * i] : p0[4 * i], e1 = ph ? p1[4 * i + 1] : p0[4 * i + 1], e2 = ph ? p1[4 * i + 2] : p0[4 * i + 2], e3 = ph ? p1[4 * i + 3] : p0[4 * i + 3];
                    const float Lr = __shfl_xor(e3, 32);
                    Fb[16 * T + 8 * ph + 2 * i] = ((e0 + e1) + (e2 + e3)) + (hi ? Lr : carry);
                    carry = Lr;
                }
            bf16x8 pa[4]; pack_p(pa, p0, p1);
            pv(o, lds + 32768 + T * 8192, vpo, pa);
        }
        const float lt = psum(l); const float inv = lt > 0.f ? 1.0f / lt : 0.f;
        y[0] = o[0] * (g0 * inv); y[1] = o[1] * (g0 * inv);
        if (hi == 0) ((LAS float*)(lds + 65536 + 66560))[wid * 32 + r32] = inv;
    }
    __syncthreads();
    {
        const int tk = tid >> 3, sub = tid & 7;
        LAS const float* F0 = (LAS const float*)(lds + 65536) + ((tk >> 5) * 128 + (tk & 31)) * 65;
        LAS float* imp = (LAS float*)lds + tk * 68;
        LAS const float* ivp = (LAS const float*)(lds + 65536 + 66560) + (tk >> 5) * 128 + (tk & 31);
        const float iv0 = ivp[0], iv1 = ivp[32], iv2 = ivp[64], iv3 = ivp[96];
        float vj[8];
#pragma unroll
        for (int i = 0; i < 8; ++i) { const int j = 8 * sub + i;
            float v = ((F0[j] * iv0 + F0[32 * 65 + j] * iv1) + F0[64 * 65 + j] * iv2) + F0[96 * 65 + j] * iv3;
            if (j == 0 || j == tb || j == tb - 1) v = INFINITY;
            if (j > tb) v = -INFINITY;
            vj[i] = v; }
        *(LAS f32x4*)(imp + 8 * sub) = (f32x4){vj[0], vj[1], vj[2], vj[3]}; *(LAS f32x4*)(imp + 8 * sub + 4) = (f32x4){vj[4], vj[5], vj[6], vj[7]};
        __syncthreads();
        int rank[8];
#pragma unroll
        for (int i = 0; i < 8; ++i) rank[i] = 0;
#pragma unroll 2
        for (int c4 = 0; c4 < 16; ++c4) {
            const f32x4 vv = *(LAS const f32x4*)(imp + 4 * c4);
#pragma unroll
            for (int e = 0; e < 4; ++e) { const int jj = 4 * c4 + e; const float x = vv[e];
#pragma unroll
                for (int i = 0; i < 8; ++i) rank[i] += (int)(x > vj[i]) | ((int)(x == vj[i]) & (int)(jj < 8 * sub + i)); }
        }
        unsigned bits = 0u;
#pragma unroll
        for (int i = 0; i < 8; ++i) if (rank[i] < 16 && 8 * sub + i <= tb) bits |= 1u << i;
        bits <<= 8 * (sub & 3);
        __hip_atomic_fetch_or(maskw + 2 * tk + (sub >> 2), bits, __ATOMIC_RELAXED, __HIP_MEMORY_SCOPE_WORKGROUP);
        __hip_atomic_fetch_or(uni + (sub >> 2), bits, __ATOMIC_RELAXED, __HIP_MEMORY_SCOPE_WORKGROUP);
        __syncthreads();
    }
    const unsigned long long mymask = ((unsigned long long)maskw[2 * tq + 1] << 32) | maskw[2 * tq];
    const unsigned long long um = ((unsigned long long)(unsigned)__builtin_amdgcn_readfirstlane((int)uni[1]) << 32) | (unsigned)__builtin_amdgcn_readfirstlane((int)uni[0]);
    const size_t brow = (size_t)b * SEQ;
    bf16x8 qr[4];
#pragma unroll
    for (int d0 = 0; d0 < 4; ++d0) qr[d0] = *(const bf16x8*)(QR + row * 512 + 64 * h + 16 * d0 + 8 * hi);
    LAS float* ypark = (LAS float*)(lds + 65536) + tid;
#pragma unroll
    for (int r = 0; r < 16; ++r) { ypark[r * 512] = y[0][r]; ypark[(16 + r) * 512] = y[1][r]; }
    LAS unsigned* tab = (LAS unsigned*)(lds + MISC_OFF + 1024);
    {
        if (tid < 64 && ((um >> tid) & 1ull)) tab[__builtin_popcountll(um & ((1ull << tid) - 1ull))] = (unsigned)tid | ((unsigned)tid << 6) | (tid == tb ? TT_CAUSAL : 0u);
        __syncthreads();
        float l; f32x16 o[2] = {zero16, zero16};
        run_tiles<true>(lds, tab, __builtin_popcountll(um), P + brow * LDP + 768 + 64 * g, P + brow * LDP + 896 + 64 * g, qr, o, l, mymask, 32 * ts, wid, lane, r32, hi, vpo);
        const float lt = psum(l); const float sc = lt > 0.f ? g1 / lt : 0.f;
#pragma unroll
        for (int r = 0; r < 16; ++r) { ypark[r * 512] += o[0][r] * sc; ypark[(16 + r) * 512] += o[1][r] * sc; }
    }
    {
        const int j0 = tb >= 8 ? tb - 8 : 0, nw = tb - j0 + 1;
        if (tid < nw) { const int j = j0 + tid; tab[tid] = (unsigned)j | TT_ALWAYS | (j == tb ? TT_CAUSAL : 0u) | ((tb >= 8 && j == tb - 8) ? TT_LOWER : 0u); }
        __syncthreads();
        float l; f32x16 o[2] = {zero16, zero16};
        run_tiles<false>(lds, tab, nw, P + brow * LDP + 1024 + 64 * g, P + brow * LDP + 1152 + 64 * g, qr, o, l, 0ull, 32 * ts, wid, lane, r32, hi, vpo);
        const float lt = psum(l); const float sc = lt > 0.f ? g2 / lt : 0.f;
#pragma unroll
        for (int r = 0; r < 16; ++r) { y[0][r] = ypark[r * 512] + o[0][r] * sc; y[1][r] = ypark[(16 + r) * 512] + o[1][r] * sc; }
    }
    store_y(YN + row * 512 + 64 * h, y, hi);
}

template <int DBG = 0> __device__ __forceinline__ void moba_item(LAS unsigned char* lds, const bf16* P, const bf16* KMH, const bf16* KML, bf16* YM, int b, int h, int ob, int wid, int lane_in, int tid_in) {
    int lane = lane_in, tid = tid_in; asm volatile("" : "+v"(lane), "+v"(tid));
    const int r32 = lane & 31, hi = lane >> 5, tq = 32 * wid + r32, t = 256 * ob + tq; const size_t row = (size_t)b * SEQ + t;
    bf16x8 qr[4];
#pragma unroll
    for (int d0 = 0; d0 < 4; ++d0) qr[d0] = *(const bf16x8*)(P + row * LDP + 1280 + 64 * h + 16 * d0 + 8 * hi);
    LAS unsigned* uni = (LAS unsigned*)(lds + MISC_OFF + 776);
    const int vpo = vpo_of(lane);
    const f32x16 zero16 = {0.f, 0.f, 0.f, 0.f, 0.f, 0.f, 0.f, 0.f, 0.f, 0.f, 0.f, 0.f, 0.f, 0.f, 0.f, 0.f};
    if (tid == 0) uni[0] = 0u;
    __syncthreads();
    unsigned mymask = 0u;
    if (ob > 0) {
        f32x16 ga = zero16;
        const bf16* kh = KMH + ((size_t)(b * 8 + h) * 16 + (r32 & 15)) * 64 + 8 * hi; const bf16* kl = KML + ((size_t)(b * 8 + h) * 16 + (r32 & 15)) * 64 + 8 * hi;
#pragma unroll
        for (int d0 = 0; d0 < 4; ++d0) { const bf16x8 ah = *(const bf16x8*)(kh + 16 * d0), al = *(const bf16x8*)(kl + 16 * d0);
            ga = __builtin_amdgcn_mfma_f32_32x32x16_bf16(ah, qr[d0], ga, 0, 0, 0); ga = __builtin_amdgcn_mfma_f32_32x32x16_bf16(al, qr[d0], ga, 0, 0, 0); }
        float gv[16];
#pragma unroll
        for (int rr = 0; rr < 8; ++rr) { const float a = ga[rr], bb = __shfl_xor(a, 32); const int n0 = (rr & 3) + 8 * (rr >> 2); gv[n0] = hi ? bb : a; gv[n0 + 4] = hi ? a : bb; }
#pragma unroll
        for (int pick = 0; pick < 3; ++pick) { float best = -INFINITY; int bi = -1;
#pragma unroll
            for (int n = 0; n < 16; ++n) if (n < ob && !((mymask >> n) & 1u) && gv[n] > best) { best = gv[n]; bi = n; }
            if (bi >= 0) mymask |= 1u << bi; }
        unsigned umw = 0u;
#pragma unroll
        for (int n = 0; n < 16; ++n) if (__ballot((mymask >> n) & 1u)) umw |= 1u << n;
        if (lane == 0) __hip_atomic_fetch_or(uni, umw, __ATOMIC_RELAXED, __HIP_MEMORY_SCOPE_WORKGROUP);
    }
    __syncthreads();
    const unsigned um = (unsigned)__builtin_amdgcn_readfirstlane((int)uni[0]);
    const size_t brow = (size_t)b * SEQ;
    LAS unsigned* tab = (LAS unsigned*)(lds + MISC_OFF + 1024);
    if (tid < 4) tab[tid] = (unsigned)(4 * ob + tid) | TT_ALWAYS | TT_CAUSAL | ((unsigned)tid << 14);
    if (tid >= 64 && tid < 80) { const int nb = tid - 64;
        if ((um >> nb) & 1u) { const int base = 4 + 4 * __builtin_popcount(um & ((1u << nb) - 1u));
#pragma unroll
            for (int kt = 0; kt < 4; ++kt) tab[base + kt] = (unsigned)(4 * nb + kt) | ((unsigned)nb << 6); } }
    __syncthreads();
    float l; f32x16 o[2] = {zero16, zero16};
    run_tiles<true, DBG, (DBG == 0)>(lds, tab, 4 + 4 * __builtin_popcount(um), P + brow * LDP + 1792 + 64 * h, P + brow * LDP + 2304 + 64 * h, qr, o, l, (unsigned long long)mymask, 32 * wid, wid, lane, r32, hi, vpo);
    f32x16 y[2] = {zero16, zero16};
    fin_add(y, o, l, 1.0f);
    store_y(YM + row * 512 + 64 * h, y, hi);
}
}

__device__ __forceinline__ float gelu_tanh(float x) { const float y = 0.7978845608028654f * (x + 0.044715f * x * x * x); const float e = __expf(2.f * y); const float th = 1.f - 2.f / (e + 1.f); return 0.5f * x * (1.f + th); }
__device__ __forceinline__ void cmp_bias_item(LAS unsigned char* lds, const float* pe, const float* w1, float* biasout, int tid) {
    LAS float* bp = (LAS float*)lds;
    const int n = tid & 63, pt = tid >> 6; float s = 0.f;
#pragma unroll 8
    for (int k = 256 * pt; k < 256 * pt + 256; ++k) s += pe[k] * w1[(size_t)k * 64 + n];
    bp[pt * 64 + n] = s;
    __syncthreads();
    if (tid < 64) { float t = 0.f;
#pragma unroll
        for (int w = 0; w < 8; ++w) t += bp[w * 64 + tid];
        biasout[tid] = t; }
    __syncthreads();
}
__device__ __forceinline__ void compress_item(LAS unsigned char* lds, const bf16* P, const bf16* W1T, const float* bias, const float* w2, bf16* OUT, int kv, int b, int g, int rt, int wid, int lane, int tid) {
    LAS float* part = (LAS float*)lds;
    LAS float* Hs = (LAS float*)(lds + 65536);
    LAS float* W2s = (LAS float*)(lds + 65536 + 8192);
    const int r32 = lane & 31, hi = lane >> 5;
    __syncthreads();
#pragma unroll
    for (int jj = 0; jj < 2; ++jj) *(LAS f32x4*)(W2s + 4 * (tid + 512 * jj)) = *(const f32x4*)(w2 + 4 * (tid + 512 * jj));
    const bf16* Asrc = P + (size_t)b * SEQ * LDP + 512 + 128 * kv + 64 * g;
    const int rowi = rt * 32 + r32, rowc = rowi < 255 ? rowi : 254;
    f32x16 c0 = {0.f, 0.f, 0.f, 0.f, 0.f, 0.f, 0.f, 0.f, 0.f, 0.f, 0.f, 0.f, 0.f, 0.f, 0.f, 0.f}, c1 = c0;
#pragma unroll 8
    for (int ks = 0; ks < 16; ++ks) {
        const int l = wid * 4 + (ks >> 2), d = (ks & 3) * 16 + 8 * hi, k = wid * 256 + ks * 16 + 8 * hi;
        const bf16x8 a = *(const bf16x8*)(Asrc + (size_t)(16 * rowc + l) * LDP + d);
        const bf16x8 b0 = *(const bf16x8*)(W1T + (size_t)r32 * 2048 + k), b1 = *(const bf16x8*)(W1T + (size_t)(32 + r32) * 2048 + k);
        c0 = __builtin_amdgcn_mfma_f32_32x32x16_bf16(a, b0, c0, 0, 0, 0); c1 = __builtin_amdgcn_mfma_f32_32x32x16_bf16(a, b1, c1, 0, 0, 0);
    }
#pragma unroll
    for (int r = 0; r < 16; ++r) { const int i = att::crow(r, hi); part[(wid * 32 + i) * 64 + r32] = c0[r]; part[(wid * 32 + i) * 64 + 32 + r32] = c1[r]; }
    __syncthreads();
#pragma unroll
    for (int jj = 0; jj < 4; ++jj) { const int e = tid + 512 * jj, n = e & 63; float s = 0.f;
#pragma unroll
        for (int w = 0; w < 8; ++w) s += part[w * 2048 + e];
        Hs[e] = gelu_tanh(s + bias[n]); }
    __syncthreads();
#pragma unroll
    for (int jj = 0; jj < 4; ++jj) { const int e = tid + 512 * jj, i = e >> 6, c = e & 63; float s = 0.f;
#pragma unroll 16
        for (int j = 0; j < 64; ++j) s += Hs[i * 64 + j] * W2s[j * 64 + c];
        const int ro = rt * 32 + i;
        OUT[((size_t)(b * 2 + g) * 256 + ro) * 64 + c] = (ro < 255) ? (bf16)f2bf(s) : (bf16)0; }
}
__device__ __forceinline__ void kmean_item(LAS unsigned char* lds, const bf16* P, bf16* KMH, bf16* KML, int b, int n, int tid) {
    LAS float* ps = (LAS float*)lds;
    const int cg = tid & 63, rg = tid >> 6;
    const bf16* src = P + ((size_t)b * SEQ + 256 * n + 32 * rg) * LDP + 1792 + 8 * cg;
    float a[8] = {0.f, 0.f, 0.f, 0.f, 0.f, 0.f, 0.f, 0.f};
    __syncthreads();
#pragma unroll 8
    for (int i = 0; i < 32; ++i) { const v4u w = *(const v4u*)(src + (size_t)i * LDP);
        a[0] += bflo(w.x); a[1] += bfhi(w.x); a[2] += bflo(w.y); a[3] += bfhi(w.y); a[4] += bflo(w.z); a[5] += bfhi(w.z); a[6] += bflo(w.w); a[7] += bfhi(w.w); }
#pragma unroll
    for (int j = 0; j < 8; ++j) ps[rg * 512 + 8 * cg + j] = a[j];
    __syncthreads();
    float s = 0.f;
#pragma unroll
    for (int w = 0; w < 8; ++w) s += ps[w * 512 + tid];
    s *= (1.0f / 256.0f);
    const unsigned hb = f2bf(s); const float hf = __uint_as_float(hb << 16);
    const int h = tid >> 6, d = tid & 63; const size_t o = ((size_t)(b * 8 + h) * 16 + n) * 64 + d;
    KMH[o] = (bf16)hb; KML[o] = (bf16)f2bf(s - hf);
}

#ifndef MK_DUMMY_MOBA
#define MK_DUMMY_MOBA 0
#endif
#ifndef MK_REP_NSA
#define MK_REP_NSA 0
#endif
#ifndef MK_REP_MOBA
#define MK_REP_MOBA 0
#endif
#ifndef MK_REP
#define MK_REP 0
#endif
#ifndef MK_PH
#define MK_PH 0x3ff
#endif
struct Args { const float* in[16]; float* out; unsigned char* ws; };
#ifndef MK_SKIP_NSA
#define MK_SKIP_NSA 0
#endif
#ifndef MK_SKIP_MOBA
#define MK_SKIP_MOBA 0
#endif
__global__ void __launch_bounds__(NWAVES * 64, 2) mega_fwd(Args a) {
    extern __shared__ __attribute__((aligned(16))) unsigned char lds_raw[];
    LAS unsigned char* lds = (LAS unsigned char*)lds_raw;
    const int tid = threadIdx.x, lane = tid & 63, wave = __builtin_amdgcn_readfirstlane(tid >> 6);
    const int G = gridDim.x, bx = blockIdx.x; const int vcu = (G % 8 == 0) ? (bx % 8) * (G / 8) + bx / 8 : bx;
    unsigned char* ws = a.ws;
    const float* x = a.in[0]; const float* norm1_g = a.in[1]; const float* w_in = a.in[2]; const float* pe_k = a.in[3]; const float* pe_v = a.in[4];
    const float* ck_w1 = a.in[5]; const float* ck_w2 = a.in[6]; const float* cv_w1 = a.in[7]; const float* cv_w2 = a.in[8];
    const float* w_upn = a.in[9]; const float* w_upm = a.in[10]; const float* w_out = a.in[11]; const float* norm2_g = a.in[12];
    const float* w_ff1 = a.in[13]; const float* w_ff2 = a.in[14]; const float* normf_g = a.in[15];
    float* out = a.out;
    bf16* WIN = (bf16*)(ws + WS_WIN); bf16* WUPN = (bf16*)(ws + WS_WUPN); bf16* WUPM = (bf16*)(ws + WS_WUPM); bf16* WOUT = (bf16*)(ws + WS_WOUT);
    bf16* WFF1 = (bf16*)(ws + WS_WFF1); bf16* WFF2 = (bf16*)(ws + WS_WFF2); bf16* WC1K = (bf16*)(ws + WS_WC1K); bf16* WC1V = (bf16*)(ws + WS_WC1V);
    float* ROPE = (float*)(ws + WS_ROPE); bf16* KC = (bf16*)(ws + WS_KC); bf16* VC = (bf16*)(ws + WS_VC); bf16* KMH = (bf16*)(ws + WS_KMH); bf16* KML = (bf16*)(ws + WS_KML);
    float* CBIAS = (float*)(ws + WS_KML + 192 * 1024); float* SSQ = (float*)(ws + WS_SSQ);
    float* GN = (float*)(ws + WS_GN); bf16* QR = (bf16*)(ws + WS_QR); bf16* HN = (bf16*)(ws + WS_HN); bf16* YN = (bf16*)(ws + WS_YN); bf16* YM = (bf16*)(ws + WS_YM);
    bf16* MIX = (bf16*)(ws + WS_MIX); bf16* P = (bf16*)(ws + WS_P); bf16* U = (bf16*)(ws + WS_U);
    gu32* ctl = (gu32*)(ws + WS_CTL);

    for (int u = tid; u < (LDS_BYTES - MISC_OFF) / 4; u += NWAVES * 64) ((LAS unsigned*)(lds + MISC_OFF))[u] = 0u;
    __syncthreads();
    XcdBarrier bar = xcd_barrier_post((unsigned*)(ctl + CW_BAR), (volatile LAS unsigned*)(lds + MISC_OFF) + 8);

#if (MK_PH >> 0) & 1
    for (int rep_ = 0; rep_ < 1 + ((MK_REP >> 0) & 1); ++rep_) {
    {
        LAS float* scr = (LAS float*)(lds + wave * 16384);
        const int gw = vcu * NWAVES + wave, NGW = G * NWAVES;
        constexpr int I_WIN = 16 * 160, I_UP = 8 * 32, I_OUT = 16 * 32, I_FF1 = 16 * 128, I_FF2 = 64 * 32, I_C1 = 32 * 2;
        constexpr int NITEMS = I_WIN + 2 * I_UP + I_OUT + I_FF1 + I_FF2 + 2 * I_C1;
        for (int it = gw; it < NITEMS; it += NGW) {
            int r = it;
            if (r < I_WIN) { transpose_item(w_in, 1024, INW, NPROJ, WIN, scr, r, lane, true); continue; } r -= I_WIN;
            if (r < I_UP) { transpose_item(w_upn, 512, 1024, 1024, WUPN, scr, r, lane, false); continue; } r -= I_UP;
            if (r < I_UP) { transpose_item(w_upm, 512, 1024, 1024, WUPM, scr, r, lane, false); continue; } r -= I_UP;
            if (r < I_OUT) { transpose_item(w_out, 1024, 1024, 1024, WOUT, scr, r, lane, false); continue; } r -= I_OUT;
            if (r < I_FF1) { transpose_item(w_ff1, 1024, 4096, 4096, WFF1, scr, r, lane, false); continue; } r -= I_FF1;
            if (r < I_FF2) { transpose_item(w_ff2, 4096, 1024, 1024, WFF2, scr, r, lane, false); continue; } r -= I_FF2;
            if (r < I_C1) { transpose_item(ck_w1, 2048, 64, 64, WC1K, scr, r, lane, false); continue; } r -= I_C1;
            transpose_item(cv_w1, 2048, 64, 64, WC1V, scr, r, lane, false);
        }
        for (int idx = gw * 64 + lane; idx < SEQ * 8; idx += NGW * 64) {
            const int pos = idx >> 3, i = idx & 7;
            const float inv = powf(500000.0f, -(float)i * 0.125f), ang = (float)pos * inv;
            ROPE[pos * 16 + i] = cosf(ang); ROPE[pos * 16 + 8 + i] = sinf(ang);
        }
        for (int m = gw; m < NTOK; m += NGW) rms_row<false>(x + (size_t)m * DMODEL, norm1_g, HN + (size_t)m * DMODEL, lane);
        if (bx < 2) { __syncthreads(); cmp_bias_item(lds, bx ? pe_v : pe_k, bx ? cv_w1 : ck_w1, CBIAS + 64 * bx, tid); }
    }
    xcd_barrier(bar);

    }
#endif
#if (MK_PH >> 1) & 1
    for (int rep_ = 0; rep_ < 1 + ((MK_REP >> 1) & 1); ++rep_) {
    {
        pg8::Gemm g{HN, WIN, HN, WIN, NTOK, NPROJ, DMODEL}; pg8::StaticOrder S; S.init(NTOK, NPROJ, G, bx);
        EpiProj E{P, QR, GN, ROPE};
        pg8::gemm_phase<EpiProj, pg8::StaticOrder, true, true>(lds, g, S, E);
    }
    xcd_barrier(bar);

    }
#endif
#if (MK_PH >> 2) & 1
    for (int rep_ = 0; rep_ < 1 + ((MK_REP >> 2) & 1); ++rep_) {
    for (int it = vcu; it < 256; it += G) {
        const int kv = it >> 7, b = (it >> 4) & 7, g = (it >> 3) & 1, rt = it & 7;
        compress_item(lds, P, kv ? WC1V : WC1K, CBIAS + 64 * kv, kv ? cv_w2 : ck_w2, kv ? VC : KC, kv, b, g, rt, wave, lane, tid);
    }
    for (int it = (vcu + 128) % G; it < 128; it += G) kmean_item(lds, P, KMH, KML, it >> 4, it & 15, tid);
    xcd_barrier(bar);

    }
#endif
#if (MK_PH >> 3) & 1
    for (int rep_ = 0; rep_ < 1 + ((MK_REP >> 3) & 1); ++rep_) {
    {
#if MK_SKIP_NSA
        for (size_t i = (size_t)bx * 512 + tid; i < (size_t)NTOK * 512 / 8; i += (size_t)G * 512) ((v4u*)YN)[i] = (v4u){0u, 0u, 0u, 0u};
#else
        for (int rn_ = 0; rn_ < 1 + MK_REP_NSA; ++rn_)
        for (int it = vcu; it < 256; it += G) {
            const int bg = it >> 4, s = it & 15;
#pragma unroll 1
            for (int k = 0; k < 4; ++k) { const int tb = (k == 0) ? 63 - s : (k == 1) ? 32 + s : (k == 2) ? 31 - s : s;
                att::nsa_item(lds, P, QR, GN, KC, VC, YN, bg >> 1, bg & 1, tb, wave, lane, tid); }
        }
    }
#endif
#if MK_SKIP_MOBA
        for (size_t i = (size_t)bx * 512 + tid; i < (size_t)NTOK * 512 / 8; i += (size_t)G * 512) ((v4u*)YM)[i] = (v4u){0u, 0u, 0u, 0u};
#else
#if MK_DUMMY_MOBA
        for (int it = vcu; it < 256; it += G) {
            const int bh = it >> 2, s = it & 3;
#pragma unroll 1
            for (int k = 0; k < 4; ++k) { const int ob = (k == 0) ? 15 - s : (k == 1) ? 8 + s : (k == 2) ? 7 - s : s;
                att::moba_item<MK_DUMMY_MOBA>(lds, P, KMH, KML, MIX, bh >> 3, bh & 7, ob, wave, lane, tid); }
        }
#endif
        for (int rm_ = 0; rm_ < 1 + MK_REP_MOBA; ++rm_)
        for (int it = vcu; it < 256; it += G) {
            const int grp = it >> 4, j = it & 15;
#pragma unroll 1
            for (int k = 0; k < 4; ++k) { const int bh = grp * 4 + k; const int ob = (k & 1) ? 15 - j : j;
                att::moba_item(lds, P, KMH, KML, YM, bh >> 3, bh & 7, ob, wave, lane, tid); }
        }
#endif
#if MK_TPROBE
        __syncthreads();
        if (bx == 0 && tid == 0) { const unsigned long long sum = *(LAS unsigned long long*)(lds + MISC_OFF + 1536); const unsigned cnt = *(LAS unsigned*)(lds + MISC_OFF + 1544);
            ((float*)(ws + WS_CTL))[8192] = cnt ? (float)sum / (float)cnt : 0.f; }
#endif
    }
    xcd_barrier(bar);

#endif
#if (MK_PH >> 4) & 1
    for (int rep_ = 0; rep_ < 1 + ((MK_REP >> 4) & 1); ++rep_) {
    {
        pg8::Gemm g{YN, WUPN, YM, WUPM, NTOK, DMODEL, 512}; pg8::PairOrder S; S.init(NTOK, DMODEL, G, bx);
        EpiMerge E{P, MIX};
        pg8::gemm_phase<EpiMerge, pg8::PairOrder, true, true>(lds, g, S, E);
    }
    xcd_barrier(bar);

    }
#endif
#if (MK_PH >> 5) & 1
    for (int rep_ = 0; rep_ < 1 + ((MK_REP >> 5) & 1); ++rep_) {
    {
        pg8::Gemm g{MIX, WOUT, MIX, WOUT, NTOK, DMODEL, DMODEL}; pg8::StaticOrder S; S.init(NTOK, DMODEL, G, bx);
        EpiResNorm E{x, out, HN, norm2_g, SSQ};
        pg8::gemm_phase<EpiResNorm, pg8::StaticOrder, true, true>(lds, g, S, E);
    }
    xcd_barrier(bar);

    }
#endif
#if (MK_PH >> 7) & 1
    for (int rep_ = 0; rep_ < 1 + ((MK_REP >> 7) & 1); ++rep_) {
    {
        pg8::Gemm g{HN, WFF1, HN, WFF1, NTOK, DFF, DMODEL}; pg8::StaticOrder S; S.init(NTOK, DFF, G, bx);
        EpiRelu2 E{U, SSQ};
        pg8::gemm_phase<EpiRelu2, pg8::StaticOrder, true, true>(lds, g, S, E);
    }
    xcd_barrier(bar);

    }
#endif
#if (MK_PH >> 8) & 1
    for (int rep_ = 0; rep_ < 1 + ((MK_REP >> 8) & 1); ++rep_) {
    {
        pg8::Gemm g{U, WFF2, U, WFF2, NTOK, DMODEL, DFF}; pg8::StaticOrder S; S.init(NTOK, DMODEL, G, bx);
        EpiRes E{out, out};
        pg8::gemm_phase<EpiRes, pg8::StaticOrder, true, true>(lds, g, S, E);
    }
    xcd_barrier(bar);

    }
#endif
#if (MK_PH >> 9) & 1
    for (int rep_ = 0; rep_ < 1 + ((MK_REP >> 9) & 1); ++rep_) {
    {
        const int gw = vcu * NWAVES + wave, NGW = G * NWAVES;
#if MK_TPROBE
        const float tpv = ((const float*)(ws + WS_CTL))[8192];
        const float tpd = sqrtf(tpv * (MK_TPROBE == 6 ? 4e-7f : 2e-8f));
        for (int m = gw; m < NTOK; m += NGW) { rms_row<true>(out + (size_t)m * DMODEL, normf_g, out + (size_t)m * DMODEL, lane);
            f32x4* orow = (f32x4*)(out + (size_t)m * DMODEL) + lane;
#pragma unroll
            for (int j = 0; j < 4; ++j) orow[64 * j] = orow[64 * j] + tpd; }
#else
        for (int m = gw; m < NTOK; m += NGW) rms_row<true>(out + (size_t)m * DMODEL, normf_g, out + (size_t)m * DMODEL, lane);
#endif
    }
    }
#endif
}

extern "C" void kernel_launch(void* const* d_in, const int* in_sizes, int n_in, void* d_out, int out_size, void* d_ws, size_t ws_size, hipStream_t stream) {
    static int grid = 0;
    if (grid == 0) {
        if (n_in != 16 || in_sizes[0] != NTOK * DMODEL || out_size != NTOK * DMODEL || ws_size < WS_END) {
            fprintf(stderr, "kernel_launch: unexpected shapes (n_in %d, in0 %d, out %d, ws %zu); nothing launched\n", n_in, n_in > 0 ? in_sizes[0] : -1, out_size, ws_size); grid = -1; return; }
        int dev = 0, cus = 0, per_cu = 0;
        if (hipGetDevice(&dev) != hipSuccess || hipDeviceGetAttribute(&cus, hipDeviceAttributeMultiprocessorCount, dev) != hipSuccess) { fprintf(stderr, "kernel_launch: device query failed\n"); grid = -1; return; }
        if (hipFuncSetAttribute((const void*)mega_fwd, hipFuncAttributeMaxDynamicSharedMemorySize, LDS_BYTES) != hipSuccess) { fprintf(stderr, "kernel_launch: hipFuncSetAttribute failed\n"); grid = -1; return; }
        if (hipOccupancyMaxActiveBlocksPerMultiprocessor(&per_cu, (const void*)mega_fwd, NWAVES * 64, LDS_BYTES) != hipSuccess || per_cu < 1)
            fprintf(stderr, "kernel_launch: note: occupancy query reports %d workgroups per CU\n", per_cu);
        (void)hipGetLastError();
        grid = cus;
    }
    if (grid < 0) return;
    if (hipMemsetAsync((char*)d_ws + WS_CTL, 0, CTL_ZERO_BYTES, stream) != hipSuccess) { fprintf(stderr, "kernel_launch: hipMemsetAsync failed\n"); return; }
    Args a{};
    for (int i = 0; i < 16; ++i) a.in[i] = (const float*)d_in[i];
    a.out = (float*)d_out; a.ws = (unsigned char*)d_ws;
    hipLaunchKernelGGL(mega_fwd, dim3(grid), dim3(NWAVES * 64), LDS_BYTES, stream, a);
    const hipError_t le = hipPeekAtLastError();
    if (le != hipSuccess) fprintf(stderr, "kernel_launch: launch failed: %s\n", hipGetErrorName(le));
}
```

```cpp
#include <hip/hip_runtime.h>
#include <cstdio>
#include <cstdint>
#include <cmath>
#ifndef MK_LAUNDER_GEMM
#define MK_LAUNDER_GEMM 1
#endif
#ifndef MK_KPHASE
#define MK_KPHASE 0
#endif
namespace pg8 {
#define PG8_LAS __attribute__((address_space(3)))
typedef unsigned short bf16_t;
typedef short bf16x8 __attribute__((ext_vector_type(8)));
typedef float f32x4 __attribute__((ext_vector_type(4)));
typedef unsigned u32x4 __attribute__((ext_vector_type(4)));
constexpr int BM = 256, BK = 64, HALF = 128, HTB = HALF * BK * 2  , STAGE_BYTES = 8 * HTB, NXCD = 8, WGM = 8;

__host__ __device__ __forceinline__ int lds_byte(int r, int c) { const int st = (r >> 4) * 2 + (c >> 5), rr = r & 15, cc = c & 31, ob = rr * 64 + cc * 2; return st * 1024 + (ob ^ (((ob >> 9) & 1) << 5)); }
__host__ __device__ __forceinline__ void stage_rc(int b, int& R, int& C) { const int st = b / 1024, sb = b % 1024, swz = sb ^ (((sb >> 9) & 1) << 5); R = (st >> 1) * 16 + swz / 64; C = (st & 1) * 32 + (swz % 64) / 2; }
__host__ __device__ __forceinline__ int perm32(int rho) { const int n = rho >> 4, i = rho & 15; return 8 * (i >> 2) + 4 * n + (i & 3); }

struct Unit { int pm, pn, src; };
struct Gemm { const bf16_t* A; const bf16_t* Bt; const bf16_t* A2; const bf16_t* Bt2; int M, N, K; };
struct StaticOrder {
    int nM, nN, nwg, G, c;
    __host__ __device__ void init(int M, int N, int G_, int c_) { nM = M / BM; nN = N / BM; nwg = nM * nN; G = G_; c = c_; }
    __host__ __device__ bool tile(long L, Unit& u) const {
        if (L >= nwg) return false;
        int wgid = (int)L; { const int q = nwg / NXCD, r = nwg % NXCD, xcd = wgid % NXCD, off = wgid / NXCD; wgid = (xcd < r ? xcd * (q + 1) : r * (q + 1) + (xcd - r) * q) + off; }
        const int nig = WGM * nN, gid = wgid / nig, fm = gid * WGM, gsz = (nM - fm) < WGM ? (nM - fm) : WGM;
        u.pm = fm + ((wgid % nig) % gsz); u.pn = (wgid % nig) / gsz; return true;
    }
    __host__ __device__ bool next(int i, Unit& u) const { u.src = 0; return tile((long)i * G + c, u); }
    __device__ __forceinline__ void a_ready(const Unit&) const {}
    __device__ __forceinline__ void done(const Unit&) const {}
};
struct PairOrder : StaticOrder {
    __host__ __device__ bool next(int i, Unit& u) const { u.src = i & 1; return tile((long)(i >> 1) * G + c, u); }
};
__device__ __forceinline__ unsigned cvt_pk_bf16(float lo, float hi) { unsigned r; asm volatile("v_cvt_pk_bf16_f32 %0, %1, %2" : "=v"(r) : "v"(lo), "v"(hi)); return r; }
template <class Epi, class Sched, bool ALIGN_EPI = false, bool SP2 = false>
__device__ __forceinline__ void gemm_phase(PG8_LAS unsigned char* lds, const Gemm g, const Sched& S, const Epi& E) {
    int tid_ = threadIdx.x;
#if MK_LAUNDER_GEMM
    asm volatile("" : "+v"(tid_));
#endif
    const int tid = tid_, wid = __builtin_amdgcn_readfirstlane(tid >> 6), lane = tid & 63, wr = wid >> 2, wc = wid & 3, fr = lane & 15, fq = lane >> 4;
    const int K = g.K, nt = K / BK;
    unsigned voffA[2], voffB[2];
#pragma unroll
    for (int i = 0; i < 2; ++i) { int R, C; stage_rc(tid * 16 + i * 8192, R, C); const int Rb = Epi::PERM ? ((R & ~31) + perm32(R & 31)) : R;
        voffA[i] = (unsigned)(R * K + C) * 2u; voffB[i] = (unsigned)(Rb * K + C) * 2u; }
    const size_t kstep = (size_t)(BK * 2);
    const size_t hstep = (size_t)HALF * K * 2;
    const size_t tstep = 2 * hstep;
    const unsigned ldsw = (unsigned)wid * 1024u;
    const int aoff = lds_byte(wr * 64 + fr, fq * 8), boff = lds_byte(wc * 32 + fr, fq * 8);
#define PG8_SA(b, h) (((b) * 2 + (h)) * HTB)
#define PG8_SB(b, h) ((4 + (b) * 2 + (h)) * HTB)
#define PG8_STAGE(bufoff, gbase, voff) do { _Pragma("unroll") for (int _i = 0; _i < 2; ++_i) \
        __builtin_amdgcn_global_load_lds((const unsigned*)((const char*)(gbase) + (voff)[_i]), (PG8_LAS unsigned*)(lds + (bufoff) + ldsw + _i * 8192), 16, 0, 0); } while (0)
#define PG8_LDA(dst, b, h) do { _Pragma("unroll") for (int m = 0; m < 4; ++m) _Pragma("unroll") for (int k = 0; k < 2; ++k) dst[m][k] = *(const PG8_LAS bf16x8*)(lds + PG8_SA(b, h) + aoff + m * 2048 + k * 1024); } while (0)
#define PG8_LDB(dst, b, h) do { _Pragma("unroll") for (int n = 0; n < 2; ++n) _Pragma("unroll") for (int k = 0; k < 2; ++k) dst[n][k] = *(const PG8_LAS bf16x8*)(lds + PG8_SB(b, h) + boff + n * 2048 + k * 1024); } while (0)
#define PG8_MMA(ai, bj, At, Bt) do { __builtin_amdgcn_s_setprio(1); _Pragma("unroll") for (int m = 0; m < 4; ++m) _Pragma("unroll") for (int n = 0; n < 2; ++n) _Pragma("unroll") for (int k = 0; k < 2; ++k) \
        acc[ai][bj][m][n] = __builtin_amdgcn_mfma_f32_16x16x32_bf16(Bt[n][k], At[m][k], acc[ai][bj][m][n], 0, 0, 0); __builtin_amdgcn_s_setprio(0); } while (0)
#define PG8_WAIT_V(n) asm volatile("s_waitcnt vmcnt(" #n ")" ::: "memory")
#define PG8_WAIT_L(n) asm volatile("s_waitcnt lgkmcnt(" #n ")" ::: "memory")
#define PG8_BAR __builtin_amdgcn_s_barrier()
#define PG8_SCHED __builtin_amdgcn_sched_barrier(0)
    Unit cur, nxt; int ui = 0;
    if (!S.next(0, cur)) return;
    f32x4 acc[2][2][4][2];
#pragma unroll
    for (int a = 0; a < 2; ++a)
#pragma unroll
        for (int b = 0; b < 2; ++b)
#pragma unroll
            for (int m = 0; m < 4; ++m)
#pragma unroll
                for (int n = 0; n < 2; ++n) acc[a][b][m][n] = (f32x4){0.f, 0.f, 0.f, 0.f};
    bf16x8 At[4][2], B0[2][2], B1[2][2];
    const char* cA = (const char*)(cur.src ? g.A2 : g.A) + (size_t)cur.pm * tstep; const char* cB = (const char*)(cur.src ? g.Bt2 : g.Bt) + (size_t)cur.pn * tstep;
    S.a_ready(cur);
    if constexpr (SP2) {
        PG8_STAGE(PG8_SB(0, 0), cB, voffB); PG8_STAGE(PG8_SB(0, 1), cB + hstep, voffB); PG8_STAGE(PG8_SA(0, 0), cA, voffA); PG8_STAGE(PG8_SA(0, 1), cA + hstep, voffA);
        if (wr == 1) PG8_BAR;
        PG8_WAIT_V(2); PG8_BAR;
        PG8_STAGE(PG8_SB(1, 0), cB + kstep, voffB); PG8_STAGE(PG8_SA(1, 0), cA + kstep, voffA); PG8_STAGE(PG8_SB(1, 1), cB + hstep + kstep, voffB);
        PG8_WAIT_V(6); PG8_BAR;
    } else {
        PG8_STAGE(PG8_SB(0, 0), cB, voffB); PG8_STAGE(PG8_SA(0, 0), cA, voffA); PG8_STAGE(PG8_SB(0, 1), cB + hstep, voffB); PG8_STAGE(PG8_SA(0, 1), cA + hstep, voffA);
        if (wr == 1) PG8_BAR;
        PG8_WAIT_V(4); PG8_BAR;
        PG8_STAGE(PG8_SB(1, 0), cB + kstep, voffB); PG8_STAGE(PG8_SA(1, 0), cA + kstep, voffA); PG8_STAGE(PG8_SB(1, 1), cB + hstep + kstep, voffB);
        PG8_WAIT_V(6); PG8_BAR;
    }
    for (;;) {
        const bool has_next = S.next(ui + 1, nxt);
        const char* nA = has_next ? (const char*)(nxt.src ? g.A2 : g.A) + (size_t)nxt.pm * tstep : cA; const char* nB = has_next ? (const char*)(nxt.src ? g.Bt2 : g.Bt) + (size_t)nxt.pn * tstep : cB;
        for (int t = 0; t < nt; t += 2) {
#if MK_KPHASE == 1
            asm volatile(".p2align 3" ::: "memory");
#elif MK_KPHASE == 2
            asm volatile(".p2align 3\n\ts_nop 0" ::: "memory");
#endif
            const bool last = (t == nt - 2);
            const char* a1 = cA + (size_t)(t + 1) * kstep;
            const char* a2 = last ? nA : cA + (size_t)(t + 2) * kstep; const char* b2 = last ? nB : cB + (size_t)(t + 2) * kstep;
            const char* a3 = a2 + kstep; const char* b3 = b2 + kstep;
            if (last && has_next) S.a_ready(nxt);
            if constexpr (SP2) {
            PG8_LDB(B0, 0, 0); PG8_LDB(B1, 0, 1); PG8_SCHED; PG8_LDA(At, 0, 0); PG8_STAGE(PG8_SA(1, 1), a1 + hstep, voffA);
            PG8_WAIT_V(8); PG8_WAIT_L(0); PG8_BAR; PG8_MMA(0, 0, At, B0); PG8_MMA(0, 1, At, B1); PG8_BAR; PG8_SCHED;
            PG8_LDA(At, 0, 1); PG8_STAGE(PG8_SB(0, 0), b2, voffB); PG8_STAGE(PG8_SB(0, 1), b2 + hstep, voffB); PG8_STAGE(PG8_SA(0, 0), a2, voffA);
            PG8_WAIT_V(8); PG8_WAIT_L(0); PG8_BAR; PG8_MMA(1, 0, At, B0); PG8_MMA(1, 1, At, B1); PG8_BAR; PG8_SCHED;
            PG8_LDB(B0, 1, 0); PG8_LDB(B1, 1, 1); PG8_SCHED; PG8_LDA(At, 1, 0); PG8_STAGE(PG8_SA(0, 1), a2 + hstep, voffA);
            PG8_WAIT_V(8); PG8_WAIT_L(0); PG8_BAR; PG8_MMA(0, 0, At, B0); PG8_MMA(0, 1, At, B1); PG8_BAR; PG8_SCHED;
            PG8_LDA(At, 1, 1); PG8_STAGE(PG8_SB(1, 0), b3, voffB); PG8_STAGE(PG8_SB(1, 1), b3 + hstep, voffB); PG8_STAGE(PG8_SA(1, 0), a3, voffA);
            PG8_WAIT_V(8); PG8_WAIT_L(0); PG8_BAR; PG8_MMA(1, 0, At, B0); PG8_MMA(1, 1, At, B1); PG8_BAR; PG8_SCHED;
            } else {
            PG8_LDB(B0, 0, 0); PG8_SCHED; PG8_LDA(At, 0, 0); PG8_STAGE(PG8_SA(1, 1), a1 + hstep, voffA);
            PG8_WAIT_L(8); PG8_BAR; PG8_WAIT_L(0); PG8_MMA(0, 0, At, B0); PG8_BAR; PG8_SCHED;
            PG8_LDB(B1, 0, 1); PG8_STAGE(PG8_SB(0, 0), b2, voffB);
            PG8_BAR; PG8_WAIT_L(0); PG8_MMA(0, 1, At, B1); PG8_BAR;
            PG8_LDA(At, 0, 1); PG8_STAGE(PG8_SA(0, 0), a2, voffA);
            PG8_BAR; PG8_WAIT_L(0); PG8_MMA(1, 0, At, B0); PG8_BAR; PG8_SCHED;
            PG8_STAGE(PG8_SB(0, 1), b2 + hstep, voffB);
            PG8_WAIT_V(6); PG8_BAR; PG8_MMA(1, 1, At, B1); PG8_BAR;
            PG8_LDB(B0, 1, 0); PG8_SCHED; PG8_LDA(At, 1, 0); PG8_STAGE(PG8_SA(0, 1), a2 + hstep, voffA);
            PG8_WAIT_L(8); PG8_BAR; PG8_WAIT_L(0); PG8_MMA(0, 0, At, B0); PG8_BAR; PG8_SCHED;
            PG8_LDB(B1, 1, 1); PG8_STAGE(PG8_SB(1, 0), b3, voffB);
            PG8_BAR; PG8_WAIT_L(0); PG8_MMA(0, 1, At, B1); PG8_BAR;
            PG8_LDA(At, 1, 1); PG8_STAGE(PG8_SA(1, 0), a3, voffA);
            PG8_BAR; PG8_WAIT_L(0); PG8_MMA(1, 0, At, B0); PG8_BAR; PG8_SCHED;
            PG8_STAGE(PG8_SB(1, 1), b3 + hstep, voffB);
            PG8_WAIT_V(6); PG8_BAR; PG8_MMA(1, 1, At, B1); PG8_BAR;
            }
        }
        if constexpr (ALIGN_EPI) { if (wr == 0) PG8_BAR; }
        if constexpr (!Epi::AFTER_DRAIN) { E(acc, cur, wr, wc, fr, fq); S.done(cur); }
        if (!has_next) break;
#pragma unroll
        for (int a = 0; a < 2; ++a)
#pragma unroll
            for (int b = 0; b < 2; ++b)
#pragma unroll
                for (int m = 0; m < 4; ++m)
#pragma unroll
                    for (int n = 0; n < 2; ++n) acc[a][b][m][n] = (f32x4){0.f, 0.f, 0.f, 0.f};
        cur = nxt; cA = nA; cB = nB; ++ui;
        if constexpr (ALIGN_EPI) { if (wr == 1) PG8_BAR; }
    }
    PG8_WAIT_V(0);
    if constexpr (!ALIGN_EPI) { if (wr == 0) PG8_BAR; }
    PG8_BAR;
    if constexpr (Epi::AFTER_DRAIN) { E.fused(acc, cur, wr, wc, fr, fq, lds, wid, lane); S.done(cur); }
#undef PG8_SA
#undef PG8_SB
#undef PG8_STAGE
#undef PG8_LDA
#undef PG8_LDB
#undef PG8_MMA
#undef PG8_WAIT_V
#undef PG8_WAIT_L
#undef PG8_BAR
#undef PG8_SCHED
}
}
#define GAS __attribute__((address_space(1)))
#define LAS __attribute__((address_space(3)))
typedef unsigned short bf16;
typedef unsigned v4u __attribute__((ext_vector_type(4)));
typedef float f32x4 __attribute__((ext_vector_type(4)));
typedef short bf16x8 __attribute__((ext_vector_type(8)));
typedef GAS unsigned gu32;
typedef GAS unsigned long long gu64;
#define RLX_AGENT __ATOMIC_RELAXED, __HIP_MEMORY_SCOPE_AGENT
#define LDS_WAIT() asm volatile("s_waitcnt lgkmcnt(0)" ::: "memory")
#define VM_WAIT() asm volatile("s_waitcnt vmcnt(0)" ::: "memory")
__device__ __forceinline__ unsigned long long rt() { return __builtin_amdgcn_s_memrealtime(); }
__device__ __forceinline__ unsigned f2bf(float f) { unsigned u = __builtin_bit_cast(unsigned, f); return (u + 0x7fffu + ((u >> 16) & 1u)) >> 16; }
__device__ __forceinline__ unsigned pk2(float lo, float hi) { return f2bf(lo) | (f2bf(hi) << 16); }

#define XB_TMO      128
#define XB_XCNT(j)  (256  + 64 * (j))
#define XB_XSUB(j)  (1280 + 64 * (j))
#define XB_XGEN(j)  (2304 + 64 * (j))
#define XB_TOP      3328
#define XB_TOPGEN   3392
#define XCD_BAR_WORDS 3456
#define XB_SPIN_CAP (1u << 18)

__device__ __forceinline__ unsigned xb_ld(unsigned* p)              { return __hip_atomic_load(p, __ATOMIC_RELAXED, __HIP_MEMORY_SCOPE_AGENT); }
__device__ __forceinline__ unsigned xb_add(unsigned* p, unsigned v) { return __hip_atomic_fetch_add(p, v, __ATOMIC_RELAXED, __HIP_MEMORY_SCOPE_AGENT); }
__device__ __forceinline__ unsigned xb_xcc_id() { return (unsigned)__builtin_amdgcn_s_getreg((3 << 11) | 20) & 0xFu; }
#define XB_SPIN(cond, bar) do { unsigned _sp = 0; while (cond) { __builtin_amdgcn_s_sleep(1); \
    if ((++_sp & 255u) == 0u) { if (xb_ld(&(bar)[XB_TMO])) break; if (_sp > XB_SPIN_CAP) { atomicAdd(&(bar)[XB_TMO], 1u); break; } } } } while (0)

struct XcdBarrier {
    unsigned* bar; unsigned x;
    volatile LAS unsigned* st;
};

__device__ __forceinline__ XcdBarrier xcd_barrier_post(unsigned* bar, volatile LAS unsigned* st) {
    XcdBarrier b; b.bar = bar; b.x = xb_xcc_id(); b.st = st;
    if (threadIdx.x == 0) (void)xb_add(&bar[XB_XCNT(b.x)], 1u);
    return b;
}
__device__ __forceinline__ void xcd_barrier_complete(unsigned* bar, unsigned x, unsigned& nloc, unsigned& nx) {
    const unsigned G = gridDim.x * gridDim.y * gridDim.z;
    unsigned sum, cnt, mine, sp = 0u;
    for (;;) {
        sum = 0u; cnt = 0u; mine = 0u;
#pragma unroll
        for (unsigned j = 0; j < 16; ++j) { const unsigned c = xb_ld(&bar[XB_XCNT(j)]); sum += c; cnt += (c > 0u) ? 1u : 0u; mine = (j == x) ? c : mine; }
        if (sum == G) break;
        __builtin_amdgcn_s_sleep(1);
        if ((++sp & 255u) == 0u) { if (xb_ld(&bar[XB_TMO])) break; if (sp > XB_SPIN_CAP) { atomicAdd(&bar[XB_TMO], 1u); break; } }
    }
    nloc = mine > 0u ? mine : 1u; nx = cnt > 0u ? cnt : 1u;
}

__device__ __forceinline__ void xcd_barrier(const XcdBarrier& b) {
    asm volatile("s_waitcnt vmcnt(0)" ::: "memory");
    __syncthreads();
    if (threadIdx.x == 0) {
        unsigned* bar = b.bar;
        __builtin_amdgcn_s_waitcnt(0);
        unsigned nloc = b.st[0], nx = b.st[1];
        if (nloc == 0u) { xcd_barrier_complete(bar, b.x, nloc, nx); b.st[0] = nloc; b.st[1] = nx; }
        const unsigned old = xb_add(&bar[XB_XSUB(b.x)], 1u);
        const unsigned gen = old / nloc;
        if (old + 1u == (gen + 1u) * nloc) {
            __builtin_amdgcn_fence(__ATOMIC_RELEASE, "agent");
            asm volatile("s_waitcnt vmcnt(0)" ::: "memory");
            const unsigned og = xb_add(&bar[XB_TOP], 1u);
            const unsigned tg = og / nx;
            if (og + 1u == (tg + 1u) * nx) xb_add(&bar[XB_TOPGEN], 1u);
            else XB_SPIN(xb_ld(&bar[XB_TOPGEN]) == tg, bar);
            __builtin_amdgcn_fence(__ATOMIC_ACQUIRE, "agent");
            xb_add(&bar[XB_XGEN(b.x)], 1u);
            asm volatile("s_waitcnt vmcnt(0)" ::: "memory");
        } else {
            XB_SPIN(xb_ld(&bar[XB_XGEN(b.x)]) == gen, bar);
            __builtin_amdgcn_fence(__ATOMIC_ACQUIRE, "agent");
            asm volatile("s_waitcnt vmcnt(0)" ::: "memory");
        }
    }
    __syncthreads();
}

typedef float f32x16 __attribute__((ext_vector_type(16)));
typedef short s16x4 __attribute__((ext_vector_type(4)));
typedef short v4i16_t __attribute__((ext_vector_type(4)));
typedef unsigned u32x2 __attribute__((ext_vector_type(2)));
typedef float f32x2_t __attribute__((ext_vector_type(2)));
typedef __bf16 bf16x2_t __attribute__((ext_vector_type(2)));

constexpr int NTOK = 32768, SEQ = 4096, DMODEL = 1024, DFF = 4096;
constexpr int LDP = 4864;
constexpr int NPROJ = 5120;
constexpr int INW = 4888;
constexpr float NORM_EPS = 1e-6f;
constexpr size_t MiB = 1u << 20;
constexpr size_t WS_CTL = 0, CTL_ZERO_BYTES = 1 * MiB;
constexpr size_t WS_WIN = 2 * MiB, WS_WUPN = 12 * MiB, WS_WUPM = 13 * MiB, WS_WOUT = 14 * MiB, WS_WFF1 = 16 * MiB, WS_WFF2 = 24 * MiB;
constexpr size_t WS_WC1K = 32 * MiB, WS_WC1V = 32 * MiB + 256 * 1024, WS_ROPE = 32 * MiB + 512 * 1024;
constexpr size_t WS_KC = 33 * MiB, WS_VC = 33 * MiB + 512 * 1024, WS_KMH = 34 * MiB, WS_KML = 34 * MiB + 256 * 1024;
constexpr size_t WS_SSQ = 460 * MiB;
constexpr size_t WS_GN = 35 * MiB;
constexpr size_t WS_QR = 40 * MiB;
constexpr size_t WS_HN = 72 * MiB;
constexpr size_t WS_YN = 72 * MiB, WS_YM = 104 * MiB;
constexpr size_t WS_MIX = 136 * MiB;
constexpr size_t WS_P = 200 * MiB;
constexpr size_t WS_U = 200 * MiB;
constexpr size_t WS_END = 504 * MiB;
constexpr int CW_BAR = 4096;

constexpr int LDS_BYTES = 147456, MISC_OFF = LDS_BYTES - 2048;
constexpr int NWAVES = 8;

__device__ __forceinline__ float bflo(unsigned w) { return __uint_as_float(w << 16); }
__device__ __forceinline__ float bfhi(unsigned w) { return __uint_as_float(w & 0xffff0000u); }
__device__ __forceinline__ unsigned cvtpk_s(float lo, float hi) { f32x2_t v = {lo, hi}; bf16x2_t b = __builtin_convertvector(v, bf16x2_t); return __builtin_bit_cast(unsigned, b); }
__device__ __forceinline__ float wave_sum(float v) {
#pragma unroll
    for (int o = 1; o < 64; o <<= 1) v += __shfl_xor(v, o);
    return v;
}
constexpr float QSCALE = 0.125f * 1.4426950408889634f;
__device__ __forceinline__ float sigmoidf_(float v) { return __builtin_amdgcn_rcpf(1.0f + __builtin_amdgcn_exp2f(-1.4426950408889634f * v)); }

struct EpiProj {
    static constexpr bool PERM = true, AFTER_DRAIN = false;
    bf16* P; bf16* QR; float* GN; const float* rope;
    __device__ __forceinline__ void operator()(const f32x4 (&acc)[2][2][4][2], const pg8::Unit& u, int wr, int wc, int fr, int fq) const {
        const int pn = u.pn; const int row0 = u.pm * 256 + wr * 64 + fr;
        const bool ropelane = ((wc & 1) == 0) && (fq < 2);
#pragma unroll
        for (int bj = 0; bj < 2; ++bj) {
            int mode;
            if (pn < 2) mode = 2; else if (pn == 2) mode = 0; else if (pn <= 4) mode = (bj == 0) ? 1 : 0; else if (pn <= 8) mode = 1; else if (pn <= 10) mode = 0; else if (pn <= 18) mode = 3; else mode = 4;
            const int col = pn * 256 + bj * 128 + wc * 32 + 8 * fq;
#pragma unroll
            for (int ai = 0; ai < 2; ++ai)
#pragma unroll
                for (int m = 0; m < 4; ++m) {
                    const int row = row0 + ai * 128 + m * 16;
                    const f32x4 a0 = acc[ai][bj][m][0], a1 = acc[ai][bj][m][1];
                    float v[8] = {a0[0], a0[1], a0[2], a0[3], a1[0], a1[1], a1[2], a1[3]};
                    if (mode == 1 || mode == 2) {
                        float pv[8], o[8];
#pragma unroll
                        for (int i = 0; i < 8; ++i) { pv[i] = __shfl_xor(v[i], 16); o[i] = v[i]; }
                        if (ropelane) {
                            const float* cs = rope + (size_t)(row & (SEQ - 1)) * 16;
                            const f32x4 c0 = *(const f32x4*)cs, c1 = *(const f32x4*)(cs + 4), s0 = *(const f32x4*)(cs + 8), s1 = *(const f32x4*)(cs + 12);
                            const float c[8] = {c0[0], c0[1], c0[2], c0[3], c1[0], c1[1], c1[2], c1[3]}, s[8] = {s0[0], s0[1], s0[2], s0[3], s1[0], s1[1], s1[2], s1[3]};
#pragma unroll
                            for (int i = 0; i < 8; ++i) o[i] = (fq == 0) ? (v[i] * c[i] - pv[i] * s[i]) : (pv[i] * s[i] + v[i] * c[i]);
                        }
                        if (mode == 2 || pn == 5 || pn == 6) {
#pragma unroll
                            for (int i = 0; i < 8; ++i) o[i] *= QSCALE;
                        }
                        if (mode == 2) {
                            v4u w; w.x = cvtpk_s(v[0], v[1]); w.y = cvtpk_s(v[2], v[3]); w.z = cvtpk_s(v[4], v[5]); w.w = cvtpk_s(v[6], v[7]);
                            *(v4u*)(P + (size_t)row * LDP + col) = w;
                            v4u w2; w2.x = cvtpk_s(o[0], o[1]); w2.y = cvtpk_s(o[2], o[3]); w2.z = cvtpk_s(o[4], o[5]); w2.w = cvtpk_s(o[6], o[7]);
                            *(v4u*)(QR + (size_t)row * 512 + col) = w2;
                        } else {
                            v4u w2; w2.x = cvtpk_s(o[0], o[1]); w2.y = cvtpk_s(o[2], o[3]); w2.z = cvtpk_s(o[4], o[5]); w2.w = cvtpk_s(o[6], o[7]);
                            *(v4u*)(P + (size_t)row * LDP + col) = w2;
                        }
                    } else if (mode == 0) {
                        v4u w; w.x = cvtpk_s(v[0], v[1]); w.y = cvtpk_s(v[2], v[3]); w.z = cvtpk_s(v[4], v[5]); w.w = cvtpk_s(v[6], v[7]);
                        *(v4u*)(P + (size_t)row * LDP + col) = w;
                    } else if (mode == 3) {
#pragma unroll
                        for (int i = 0; i < 8; ++i) v[i] = sigmoidf_(v[i]);
                        v4u w; w.x = cvtpk_s(v[0], v[1]); w.y = cvtpk_s(v[2], v[3]); w.z = cvtpk_s(v[4], v[5]); w.w = cvtpk_s(v[6], v[7]);
                        *(v4u*)(P + (size_t)row * LDP + col) = w;
                    } else {
                        if (bj == 0 && wc == 0 && fq < 3) {
                            float* gp = GN + (size_t)row * 32 + 8 * fq;
                            *(f32x4*)gp = (f32x4){sigmoidf_(v[0]), sigmoidf_(v[1]), sigmoidf_(v[2]), sigmoidf_(v[3])};
                            *(f32x4*)(gp + 4) = (f32x4){sigmoidf_(v[4]), sigmoidf_(v[5]), sigmoidf_(v[6]), sigmoidf_(v[7])};
                        }
                    }
                }
        }
    }
};
struct EpiMerge {
    static constexpr bool PERM = true, AFTER_DRAIN = false;
    const bf16* P; bf16* MIX;
    __device__ __forceinline__ void operator()(const f32x4 (&acc)[2][2][4][2], const pg8::Unit& u, int wr, int wc, int fr, int fq) const {
        const int row0 = u.pm * 256 + wr * 64 + fr; const int src = u.src;
#pragma unroll
        for (int ai = 0; ai < 2; ++ai)
#pragma unroll
            for (int m = 0; m < 4; ++m) {
                const int row = row0 + ai * 128 + m * 16;
#pragma unroll
                for (int bj = 0; bj < 2; ++bj) {
                    const int col = u.pn * 256 + bj * 128 + wc * 32 + 8 * fq;
                    const v4u gw = *(const v4u*)(P + (size_t)row * LDP + 2816 + src * 1024 + col);
                    const f32x4 a0 = acc[ai][bj][m][0], a1 = acc[ai][bj][m][1];
                    float r[8] = {a0[0] * bflo(gw.x), a0[1] * bfhi(gw.x), a0[2] * bflo(gw.y), a0[3] * bfhi(gw.y), a1[0] * bflo(gw.z), a1[1] * bfhi(gw.z), a1[2] * bflo(gw.w), a1[3] * bfhi(gw.w)};
                    bf16* mp = MIX + (size_t)row * DMODEL + col;
                    if (src) { const v4u pw = *(const v4u*)mp;
                        r[0] += bflo(pw.x); r[1] += bfhi(pw.x); r[2] += bflo(pw.y); r[3] += bfhi(pw.y); r[4] += bflo(pw.z); r[5] += bfhi(pw.z); r[6] += bflo(pw.w); r[7] += bfhi(pw.w); }
                    v4u w; w.x = cvtpk_s(r[0], r[1]); w.y = cvtpk_s(r[2], r[3]); w.z = cvtpk_s(r[4], r[5]); w.w = cvtpk_s(r[6], r[7]);
                    *(v4u*)mp = w;
                }
            }
    }
};
struct EpiRes {
    static constexpr bool PERM = false, AFTER_DRAIN = false;
    const float* base; float* out;
    __device__ __forceinline__ void operator()(const f32x4 (&acc)[2][2][4][2], const pg8::Unit& u, int wr, int wc, int fr, int fq) const {
        const int row0 = u.pm * 256 + wr * 64 + fr; const int col0 = u.pn * 256 + wc * 32 + 4 * fq;
#pragma unroll
        for (int ai = 0; ai < 2; ++ai)
#pragma unroll
            for (int m = 0; m < 4; ++m) {
                const size_t off = (size_t)(row0 + ai * 128 + m * 16) * DMODEL + col0;
#pragma unroll
                for (int bj = 0; bj < 2; ++bj)
#pragma unroll
                    for (int n = 0; n < 2; ++n) { const f32x4 bs = *(const f32x4*)(base + off + bj * 128 + n * 16); *(f32x4*)(out + off + bj * 128 + n * 16) = bs + acc[ai][bj][m][n]; }
            }
    }
};
struct EpiResNorm {
    static constexpr bool PERM = false, AFTER_DRAIN = false;
    const float* base; float* out; bf16* XB; const float* g; float* SSQ;
    __device__ __forceinline__ void operator()(const f32x4 (&acc)[2][2][4][2], const pg8::Unit& u, int wr, int wc, int fr, int fq) const {
        const int row0 = u.pm * 256 + wr * 64 + fr; const int col0 = u.pn * 256 + wc * 32 + 4 * fq;
        f32x4 gv[2][2];
#pragma unroll
        for (int bj = 0; bj < 2; ++bj)
#pragma unroll
            for (int n = 0; n < 2; ++n) gv[bj][n] = *(const f32x4*)(g + col0 + bj * 128 + n * 16);
#pragma unroll
        for (int ai = 0; ai < 2; ++ai)
#pragma unroll
            for (int m = 0; m < 4; ++m) {
                const int row = row0 + ai * 128 + m * 16; const size_t off = (size_t)row * DMODEL + col0; float ss = 0.f;
#pragma unroll
                for (int bj = 0; bj < 2; ++bj)
#pragma unroll
                    for (int n = 0; n < 2; ++n) { const f32x4 v = *(const f32x4*)(base + off + bj * 128 + n * 16) + acc[ai][bj][m][n]; *(f32x4*)(out + off + bj * 128 + n * 16) = v;
                        ss += (v.x * v.x + v.y * v.y) + (v.z * v.z + v.w * v.w);
                        const f32x4 h = v * gv[bj][n]; *(u32x2*)(XB + off + bj * 128 + n * 16) = (u32x2){cvtpk_s(h.x, h.y), cvtpk_s(h.z, h.w)}; }
                ss += __shfl_xor(ss, 16); ss += __shfl_xor(ss, 32);
                if (fq == 0) SSQ[(size_t)row * 16 + u.pn * 4 + wc] = ss;
            }
    }
};
struct EpiRelu2 {
    static constexpr bool PERM = true, AFTER_DRAIN = false;
    bf16* U; const float* SSQ;
    __device__ __forceinline__ void operator()(const f32x4 (&acc)[2][2][4][2], const pg8::Unit& u, int wr, int wc, int fr, int fq) const {
        const int row0 = u.pm * 256 + wr * 64 + fr; const int col0 = u.pn * 256 + wc * 32 + 8 * fq;
#pragma unroll
        for (int ai = 0; ai < 2; ++ai)
#pragma unroll
            for (int m = 0; m < 4; ++m) {
                bf16* rp = U + (size_t)(row0 + ai * 128 + m * 16) * DFF + col0;
                const float* sp = SSQ + (size_t)(row0 + ai * 128 + m * 16) * 16;
                const f32x4 s0 = *(const f32x4*)sp, s1 = *(const f32x4*)(sp + 4), s2 = *(const f32x4*)(sp + 8), s3 = *(const f32x4*)(sp + 12);
                const float sst = ((((s0.x + s0.y) + (s0.z + s0.w)) + ((s1.x + s1.y) + (s1.z + s1.w))) + (((s2.x + s2.y) + (s2.z + s2.w)) + ((s3.x + s3.y) + (s3.z + s3.w))));
                const float r2 = 1.0f / (sst * (1.0f / DMODEL) + NORM_EPS);
#pragma unroll
                for (int bj = 0; bj < 2; ++bj) {
                    f32x4 a0 = acc[ai][bj][m][0], a1 = acc[ai][bj][m][1];
#pragma unroll
                    for (int i = 0; i < 4; ++i) { const float x = fmaxf(a0[i], 0.f), y = fmaxf(a1[i], 0.f); a0[i] = x * x * r2; a1[i] = y * y * r2; }
                    v4u w; w.x = cvtpk_s(a0[0], a0[1]); w.y = cvtpk_s(a0[2], a0[3]); w.z = cvtpk_s(a1[0], a1[1]); w.w = cvtpk_s(a1[2], a1[3]);
                    *(v4u*)(rp + bj * 128) = w;
                }
            }
    }
};

__device__ __forceinline__ int win_src_col(int n) { return n < 1280 ? n : (n < 4864 ? n + 24 : (n < INW ? n - 3584 : -1)); }
__device__ __forceinline__ void transpose_item(const float* W, int K, int N, int Nd, bf16* WT, LAS float* scr, int item, int lane, bool remap) {
    const int nblk = Nd / 32, kb = item / nblk, nb = item % nblk, k0 = 64 * kb, n0 = 32 * nb;
    const int c4 = 4 * (lane & 7), rr = lane >> 3;
    int sc = n0 + c4; if (remap) sc = win_src_col(sc);
    f32x4 v[8];
#pragma unroll
    for (int i = 0; i < 8; ++i) v[i] = sc >= 0 ? *(const f32x4*)(W + (size_t)(k0 + 8 * i + rr) * N + sc) : (f32x4){0.f, 0.f, 0.f, 0.f};
#pragma unroll
    for (int i = 0; i < 8; ++i) { LAS float* d = scr + (8 * i + rr) * 33 + c4; d[0] = v[i].x; d[1] = v[i].y; d[2] = v[i].z; d[3] = v[i].w; }
    LDS_WAIT(); asm volatile("" ::: "memory");
    const int c = lane & 7;
#pragma unroll
    for (int j = 0; j < 4; ++j) { const int n = (lane >> 3) + 8 * j; const LAS float* s = scr + (8 * c) * 33 + n;
        v4u o; o.x = pk2(s[0 * 33], s[1 * 33]); o.y = pk2(s[2 * 33], s[3 * 33]); o.z = pk2(s[4 * 33], s[5 * 33]); o.w = pk2(s[6 * 33], s[7 * 33]);
        *(GAS v4u*)(WT + (size_t)(n0 + n) * K + k0 + 8 * c) = o; }
    LDS_WAIT(); asm volatile("" ::: "memory");
}
template <bool OUTF32> __device__ __forceinline__ void rms_row(const float* xrow, const float* g, void* orow, int lane) {
    const f32x4* xr = (const f32x4*)xrow + lane; const f32x4* gr = (const f32x4*)g + lane;
    f32x4 v[4]; float s = 0.f;
#pragma unroll
    for (int j = 0; j < 4; ++j) { v[j] = xr[64 * j]; s += (v[j].x * v[j].x + v[j].y * v[j].y) + (v[j].z * v[j].z + v[j].w * v[j].w); }
    const float rstd = 1.0f / sqrtf(wave_sum(s) * (1.0f / DMODEL) + NORM_EPS);
#pragma unroll
    for (int j = 0; j < 4; ++j) { const f32x4 gg = gr[64 * j]; const f32x4 o = v[j] * rstd * gg;
        if (OUTF32) ((f32x4*)orow + lane)[64 * j] = o;
        else ((u32x2*)orow + lane)[64 * j] = (u32x2){cvtpk_s(o.x, o.y), cvtpk_s(o.z, o.w)}; }
}

__device__ __forceinline__ void rms_row2(const float* xa, const float* xb, const float* g, bf16* oa, bf16* ob, int lane) {
    const f32x4* ra = (const f32x4*)xa + lane; const f32x4* rb = (const f32x4*)xb + lane; const f32x4* gr = (const f32x4*)g + lane;
    f32x4 va[4], vb[4]; float sa = 0.f, sb = 0.f;
#pragma unroll
    for (int j = 0; j < 4; ++j) { va[j] = ra[64 * j]; vb[j] = rb[64 * j]; }
#pragma unroll
    for (int j = 0; j < 4; ++j) { sa += (va[j].x * va[j].x + va[j].y * va[j].y) + (va[j].z * va[j].z + va[j].w * va[j].w); sb += (vb[j].x * vb[j].x + vb[j].y * vb[j].y) + (vb[j].z * vb[j].z + vb[j].w * vb[j].w); }
    const float rsa = 1.0f / sqrtf(wave_sum(sa) * (1.0f / DMODEL) + NORM_EPS), rsb = 1.0f / sqrtf(wave_sum(sb) * (1.0f / DMODEL) + NORM_EPS);
#pragma unroll
    for (int j = 0; j < 4; ++j) { const f32x4 gg = gr[64 * j]; const f32x4 pa = va[j] * rsa * gg, pb = vb[j] * rsb * gg;
        ((u32x2*)oa + lane)[64 * j] = (u32x2){cvtpk_s(pa.x, pa.y), cvtpk_s(pa.z, pa.w)}; ((u32x2*)ob + lane)[64 * j] = (u32x2){cvtpk_s(pb.x, pb.y), cvtpk_s(pb.z, pb.w)}; }
}

namespace att {
constexpr float C2 = 0.125f * 1.4426950408889634f;
__device__ __forceinline__ int crow(int r, int hi) { return (r & 3) + 8 * (r >> 2) + 4 * hi; }
__device__ __forceinline__ float pmax(float v) { auto rr = __builtin_amdgcn_permlane32_swap(__float_as_uint(v), __float_as_uint(v), false, false); return fmaxf(__uint_as_float(rr[0]), __uint_as_float(rr[1])); }
__device__ __forceinline__ float pget(float v, int hi) { auto rr = __builtin_amdgcn_permlane32_swap(__float_as_uint(v), __float_as_uint(v), false, false); return __uint_as_float(hi ? rr[0] : rr[1]); }
__device__ __forceinline__ float psum(float v) { auto rr = __builtin_amdgcn_permlane32_swap(__float_as_uint(v), __float_as_uint(v), false, false); return __uint_as_float(rr[0]) + __uint_as_float(rr[1]); }
__device__ __forceinline__ void stage_kv(LAS unsigned char* lds, int koff, int voff, const bf16* Kt, const bf16* Vt, int pitch, int wid, int lane) {
    const int r = 8 * wid + (lane >> 3), cs = lane & 7;
    const unsigned ko = (unsigned)(r * pitch + ((cs ^ ((r >> 1) & 7)) << 3)), vo = (unsigned)(r * pitch + ((cs ^ (((r >> 1) & 1) << 2)) << 3));
    const bf16* ks = Kt + ko; const bf16* vs = Vt + vo;
    __builtin_amdgcn_global_load_lds((const unsigned*)ks, (LAS unsigned*)(lds + koff + wid * 1024), 16, 0, 0);
    __builtin_amdgcn_global_load_lds((const unsigned*)vs, (LAS unsigned*)(lds + voff + wid * 1024), 16, 0, 0);
}
__device__ __forceinline__ void qkt(f32x16& p0, f32x16& p1, LAS const unsigned char* kslot, const bf16x8 (&q)[4], const f32x16& init, int r32, int hi) {
    LAS const unsigned char* kb = kslot + r32 * 128; const int sw = (r32 >> 1) & 7;
    bf16x8 kf[8];
#pragma unroll
    for (int d0 = 0; d0 < 4; ++d0) { const int x = ((2 * d0 + hi) ^ sw) << 4; kf[2 * d0] = *(LAS const bf16x8*)(kb + x); kf[2 * d0 + 1] = *(LAS const bf16x8*)(kb + x + 4096); }
    __builtin_amdgcn_sched_barrier(0);
    p0 = __builtin_amdgcn_mfma_f32_32x32x16_bf16(kf[0], q[0], init, 0, 0, 0); p1 = __builtin_amdgcn_mfma_f32_32x32x16_bf16(kf[1], q[0], init, 0, 0, 0);
#pragma unroll
    for (int d0 = 1; d0 < 4; ++d0) { p0 = __builtin_amdgcn_mfma_f32_32x32x16_bf16(kf[2 * d0], q[d0], p0, 0, 0, 0); p1 = __builtin_amdgcn_mfma_f32_32x32x16_bf16(kf[2 * d0 + 1], q[d0], p1, 0, 0, 0); }
    __builtin_amdgcn_sched_barrier(0);
}
__device__ __forceinline__ s16x4 vtr(LAS const unsigned char* p) { return __builtin_bit_cast(s16x4, __builtin_amdgcn_ds_read_tr16_b64_v4i16((LAS v4i16_t*)p)); }
__device__ __forceinline__ int vpo_of(int lane) { const int hi = lane >> 5, q = (lane & 15) >> 2, p = lane & 3, dsub = (lane >> 4) & 1; return ((4 * hi + q) * 128 + dsub * 32 + p * 8) | (((q >> 1) & 1) << 30); }
__device__ __forceinline__ void pv(f32x16 (&o)[2], LAS const unsigned char* vslot, int vpo, const bf16x8 (&pa)[4]) {
    const int vsw = ((vpo >> 30) & 1) * 64;
    LAS const unsigned char* vb = vslot + (vpo & 0xffff);
#pragma unroll
    for (int d0 = 0; d0 < 2; ++d0) {
        LAS const unsigned char* vp = vb + (d0 ? 64 - vsw : vsw);
        s16x4 lo[4], h4[4];
#pragma unroll
        for (int i = 0; i < 4; ++i) { lo[i] = vtr(vp + i * 2048); h4[i] = vtr(vp + i * 2048 + 1024); }
        __builtin_amdgcn_sched_barrier(0);
#pragma unroll
        for (int i = 0; i < 4; ++i) {
            const bf16x8 vf = {lo[i][0], lo[i][1], lo[i][2], lo[i][3], h4[i][0], h4[i][1], h4[i][2], h4[i][3]};
            o[d0] = __builtin_amdgcn_mfma_f32_32x32x16_bf16(vf, pa[i], o[d0], 0, 0, 0);
        }
        __builtin_amdgcn_sched_barrier(0);
    }
}
__device__ __forceinline__ void pack_p(bf16x8 (&pa)[4], const f32x16& p0, const f32x16& p1) {
    const v4u w0 = {cvtpk_s(p0[0], p0[1]), cvtpk_s(p0[2], p0[3]), cvtpk_s(p0[4], p0[5]), cvtpk_s(p0[6], p0[7])};
    const v4u w1 = {cvtpk_s(p0[8], p0[9]), cvtpk_s(p0[10], p0[11]), cvtpk_s(p0[12], p0[13]), cvtpk_s(p0[14], p0[15])};
    const v4u w2 = {cvtpk_s(p1[0], p1[1]), cvtpk_s(p1[2], p1[3]), cvtpk_s(p1[4], p1[5]), cvtpk_s(p1[6], p1[7])};
    const v4u w3 = {cvtpk_s(p1[8], p1[9]), cvtpk_s(p1[10], p1[11]), cvtpk_s(p1[12], p1[13]), cvtpk_s(p1[14], p1[15])};
    pa[0] = __builtin_bit_cast(bf16x8, w0); pa[1] = __builtin_bit_cast(bf16x8, w1); pa[2] = __builtin_bit_cast(bf16x8, w2); pa[3] = __builtin_bit_cast(bf16x8, w3);
}
__device__ __forceinline__ void mask_gt(f32x16& p0, f32x16& p1, int lim, int hi) {
#pragma unroll
    for (int r = 0; r < 16; ++r) { const int kk = crow(r, hi); if (kk > lim) p0[r] = -INFINITY; if (kk + 32 > lim) p1[r] = -INFINITY; }
}
__device__ __forceinline__ void mask_le(f32x16& p0, f32x16& p1, int lim, int hi) {
#pragma unroll
    for (int r = 0; r < 16; ++r) { const int kk = crow(r, hi); if (kk <= lim) p0[r] = -INFINITY; if (kk + 32 <= lim) p1[r] = -INFINITY; }
}
__device__ __forceinline__ float tile_max(const f32x16& p0, const f32x16& p1) {
    float rm = fmaxf(p0[0], p1[0]);
#pragma unroll
    for (int r = 1; r < 16; ++r) rm = fmaxf(rm, fmaxf(p0[r], p1[r]));
    return rm;
}
__device__ __forceinline__ float max3f(float a, float b, float c) { float r; asm("v_max3_f32 %0, %1, %2, %3" : "=v"(r) : "v"(a), "v"(b), "v"(c)); return r; }
__device__ __forceinline__ float max2f(float a, float b) { float r; asm("v_max_f32_e32 %0, %1, %2" : "=v"(r) : "v"(a), "v"(b)); return r; }
__device__ __forceinline__ float tile_max3(const f32x16& p0, const f32x16& p1) {
    float a = max3f(p0[0], p0[1], p1[0]), b = max3f(p0[2], p0[3], p1[1]); a = max3f(a, p1[2], p1[3]);
#pragma unroll
    for (int r = 4; r < 16; r += 4) { a = max3f(a, p0[r], p0[r + 1]); b = max3f(b, p0[r + 2], p0[r + 3]); a = max3f(a, p1[r], p1[r + 1]); b = max3f(b, p1[r + 2], p1[r + 3]); }
    return max2f(a, b);
}
__device__ __forceinline__ void fin_add(f32x16 (&y)[2], const f32x16 (&o)[2], float l, float gate) {
    const float lt = psum(l); const float sc = lt > 0.f ? gate / lt : 0.f;
    y[0] += o[0] * sc; y[1] += o[1] * sc;
}
__device__ __forceinline__ void store_y(bf16* yrow, const f32x16 (&y)[2], int hi) {
#pragma unroll
    for (int d0 = 0; d0 < 2; ++d0)
#pragma unroll
        for (int rg = 0; rg < 4; ++rg) {
            const u32x2 w = {cvtpk_s(y[d0][4 * rg], y[d0][4 * rg + 1]), cvtpk_s(y[d0][4 * rg + 2], y[d0][4 * rg + 3])};
            *(u32x2*)(yrow + 32 * d0 + 8 * rg + 4 * hi) = w;
        }
}
__device__ __forceinline__ int next_set(unsigned long long um, int from) { if (from >= 64) return 64; const unsigned long long x = um >> from; return x ? from + __builtin_ctzll(x) : 64; }


constexpr float THR = 8.0f;
#ifndef MK_AHEAD
#define MK_AHEAD 2
#endif
constexpr int AHEAD = MK_AHEAD, NSLOT = (MK_AHEAD == 2) ? 4 : 8;
__device__ __forceinline__ void glds16(const void* gsrc, unsigned lds_dst) { unsigned keep;
    asm volatile("s_mov_b32 %0, m0\n\ts_mov_b32 m0, %2\n\ts_nop 0\n\tglobal_load_lds_dwordx4 %1, off\n\ts_mov_b32 m0, %0" : "=&s"(keep) : "v"(gsrc), "s"(lds_dst) : "memory"); }
__device__ __forceinline__ void stage_kv_asm(unsigned ring_addr, int koff, int voff, const bf16* Kt, const bf16* Vt, int pitch, int wid, int lane) {
    const int r = 8 * wid + (lane >> 3), cs = lane & 7;
    const unsigned ko = (unsigned)(r * pitch + ((cs ^ ((r >> 1) & 7)) << 3)), vo = (unsigned)(r * pitch + ((cs ^ (((r >> 1) & 1) << 2)) << 3));
    glds16(Kt + ko, (unsigned)__builtin_amdgcn_readfirstlane((int)(ring_addr + koff + wid * 1024)));
    glds16(Vt + vo, (unsigned)__builtin_amdgcn_readfirstlane((int)(ring_addr + voff + wid * 1024)));
}
#define ATT_BAR() do { __builtin_amdgcn_sched_barrier(0); asm volatile("s_waitcnt lgkmcnt(0)" ::: "memory"); if (!(DBG & 8)) __builtin_amdgcn_s_barrier(); asm volatile("" ::: "memory"); __builtin_amdgcn_sched_barrier(0); } while (0)
#define ATT_WAIT_BAR(more) do { __builtin_amdgcn_sched_barrier(0); if (more) asm volatile("s_waitcnt vmcnt(2) lgkmcnt(0)" ::: "memory"); else asm volatile("s_waitcnt vmcnt(0) lgkmcnt(0)" ::: "memory"); __builtin_amdgcn_s_barrier(); asm volatile("" ::: "memory"); __builtin_amdgcn_sched_barrier(0); } while (0)
#ifndef MK_TPROBE
#define MK_TPROBE 0
#endif
#if MK_TPROBE == 6
#define TP_NOW() __builtin_amdgcn_s_memrealtime()
#else
#define TP_NOW() __builtin_amdgcn_s_memtime()
#endif
#define TP_BEGIN(seg) do { if (MK_TPROBE && TPON && (MK_TPROBE == (seg) || ((seg) == 5 && MK_TPROBE == 6))) { __builtin_amdgcn_sched_barrier(0); tp0_ = TP_NOW(); __builtin_amdgcn_sched_barrier(0); } } while (0)
#define TP_END(seg) do { if (MK_TPROBE && TPON && (MK_TPROBE == (seg) || ((seg) == 5 && MK_TPROBE == 6))) { __builtin_amdgcn_sched_barrier(0); tpacc_ += TP_NOW() - tp0_; __builtin_amdgcn_sched_barrier(0); } } while (0)
constexpr unsigned TT_ALWAYS = 1u << 12, TT_CAUSAL = 1u << 13, TT_LOWER = 1u << 16;
template <bool HAS_SEL, int DBG = 0, bool TPON = false> __device__ __forceinline__ void run_tiles(LAS unsigned char* ring, LAS const unsigned* tab, int n, const bf16* Kb, const bf16* Vb, bf16x8 (&q)[4],
                                                                      f32x16 (&o)[2], float& l, unsigned long long mymask, int tqbase, int wid, int lane, int r32, int hi, int vpo) {
    asm volatile("" : "+v"(q[0]), "+v"(q[1]), "+v"(q[2]), "+v"(q[3]));
    const bool hb = wid >= 4;
    const unsigned ring_addr = (unsigned)(size_t)ring;
    const int tq = tqbase + r32;
    float mhat = 0.f; bool started = false; l = 0.f;
    f32x16 negm = {0.f, 0.f, 0.f, 0.f, 0.f, 0.f, 0.f, 0.f, 0.f, 0.f, 0.f, 0.f, 0.f, 0.f, 0.f, 0.f};
    f32x16 p0 = negm, p1 = negm; bf16x8 pa[4]; if (DBG) { pa[0] = (bf16x8){0,0,0,0,0,0,0,0}; pa[1] = pa[0]; pa[2] = pa[0]; pa[3] = pa[0]; }
#define ATT_ISSUE(tt) do { const int ti_ = (tt) < n ? (tt) : n - 1; const unsigned dd_ = (unsigned)__builtin_amdgcn_readfirstlane((int)tab[ti_]); const size_t k0_ = (size_t)(64 * (dd_ & 63u)); \
        const int so_ = ((tt) & 3) * 16384; stage_kv_asm(ring_addr, so_, so_ + 8192, Kb + k0_ * LDP, Vb + k0_ * LDP, LDP, wid, lane); } while (0)
#define ATT_WAIT_BAR2() do { __builtin_amdgcn_sched_barrier(0); if (DBG & 4) asm volatile("s_waitcnt lgkmcnt(0)" ::: "memory"); else asm volatile("s_waitcnt vmcnt(2) lgkmcnt(0)" ::: "memory"); \
        if (!(DBG & 8)) __builtin_amdgcn_s_barrier(); asm volatile("" ::: "memory"); __builtin_amdgcn_sched_barrier(0); } while (0)
    ATT_ISSUE(0); ATT_ISSUE(1);
    ATT_WAIT_BAR2();
    if (hb) ATT_BAR();
    bool act_prev = false;
    unsigned d = (unsigned)__builtin_amdgcn_readfirstlane((int)tab[0]);
    unsigned dI = (unsigned)__builtin_amdgcn_readfirstlane((int)tab[2 < n ? 2 : n - 1]);
    unsigned long long tp0_ = 0ull, tpacc_ = 0ull;
    LAS const unsigned char* const kb0 = ring + r32 * 128; const int ksw = (r32 >> 1) & 7;
    const int vsw = ((vpo >> 30) & 1) * 64; LAS const unsigned char* const vb0 = ring + 8192 + (vpo & 0xffff);
#define ATT_EXP_HALF(P, W0, W1) do { float s_ = 0.f; _Pragma("unroll") for (int r = 0; r < 16; ++r) { P[r] = __builtin_amdgcn_exp2f(P[r]); s_ += P[r]; } l += s_; \
        { const v4u w0_ = {cvtpk_s(P[0], P[1]), cvtpk_s(P[2], P[3]), cvtpk_s(P[4], P[5]), cvtpk_s(P[6], P[7])}; const v4u w1_ = {cvtpk_s(P[8], P[9]), cvtpk_s(P[10], P[11]), cvtpk_s(P[12], P[13]), cvtpk_s(P[14], P[15])}; \
          pa[W0] = __builtin_bit_cast(bf16x8, w0_); pa[W1] = __builtin_bit_cast(bf16x8, w1_); } } while (0)
#define ATT_PV_HALF(slotbase, d0) do { LAS const unsigned char* vp_ = vb0 + (slotbase) + ((d0) ? 64 - vsw : vsw); s16x4 lo_[4], h4_[4]; \
        _Pragma("unroll") for (int i = 0; i < 4; ++i) { lo_[i] = vtr(vp_ + i * 2048); h4_[i] = vtr(vp_ + i * 2048 + 1024); } \
        __builtin_amdgcn_sched_barrier(0); \
        _Pragma("unroll") for (int i = 0; i < 4; ++i) { const bf16x8 vf_ = {lo_[i][0], lo_[i][1], lo_[i][2], lo_[i][3], h4_[i][0], h4_[i][1], h4_[i][2], h4_[i][3]}; o[d0] = __builtin_amdgcn_mfma_f32_32x32x16_bf16(vf_, pa[i], o[d0], 0, 0, 0); } \
        __builtin_amdgcn_sched_barrier(0); } while (0)
#pragma unroll 1
    for (int t = 0; t < n; ++t) {
        TP_BEGIN(5); TP_BEGIN(1);
        { const size_t k0_ = (size_t)(64 * (dI & 63u)); const int so_ = ((t + 2) & 3) * 16384; stage_kv_asm(ring_addr, so_, so_ + 8192, Kb + k0_ * LDP, Vb + k0_ * LDP, LDP, wid, lane); }
        const unsigned dI_next = tab[t + 3 < n ? t + 3 : n - 1];
        const int coff64 = (int)((d >> 14) & 3u) * 64;
        const bool causal = (d & TT_CAUSAL) != 0u;
        const bool act = !(causal && coff64 > tqbase + 31);
        bf16x8 kf[8];
        if (act && !(DBG & 2)) {
            LAS const unsigned char* kb = kb0 + (t & 3) * 16384;
#pragma unroll
            for (int d0 = 0; d0 < 4; ++d0) { const int x = ((2 * d0 + hi) ^ ksw) << 4; kf[2 * d0] = *(LAS const bf16x8*)(kb + x); kf[2 * d0 + 1] = *(LAS const bf16x8*)(kb + x + 4096); }
        }
        __builtin_amdgcn_sched_barrier(0);
        if (act_prev && !(DBG & 1)) ATT_EXP_HALF(p1, 2, 3);
        __builtin_amdgcn_sched_barrier(0);
        f32x16 q0 = p0, q1 = p1;
        (void)q0; (void)q1;
        if (act) {
            f32x16 cin = negm;
            if (HAS_SEL) { const bool sel = (d & TT_ALWAYS) || ((mymask >> ((d >> 6) & 63u)) & 1ull);
#pragma unroll
                for (int r = 0; r < 16; ++r) cin[r] = sel ? negm[r] : -INFINITY; }
            if (!(DBG & 2)) {
                p0 = __builtin_amdgcn_mfma_f32_32x32x16_bf16(kf[0], q[0], cin, 0, 0, 0); p1 = __builtin_amdgcn_mfma_f32_32x32x16_bf16(kf[1], q[0], cin, 0, 0, 0);
#pragma unroll
                for (int d0 = 1; d0 < 4; ++d0) { p0 = __builtin_amdgcn_mfma_f32_32x32x16_bf16(kf[2 * d0], q[d0], p0, 0, 0, 0); p1 = __builtin_amdgcn_mfma_f32_32x32x16_bf16(kf[2 * d0 + 1], q[d0], p1, 0, 0, 0); }
            } else { p0 = cin; p1 = cin; }
        }
        __builtin_amdgcn_sched_barrier(0);
        if (act_prev && !(DBG & 2)) { ATT_PV_HALF(((t - 1) & 3) * 16384, 0); ATT_PV_HALF(((t - 1) & 3) * 16384, 1); }
        TP_END(1); TP_BEGIN(2);
        ATT_WAIT_BAR2();
        TP_END(2); TP_BEGIN(3);
        if (act && !(DBG & 1)) {
            asm volatile("s_nop 15\n\ts_nop 7" : "+v"(p0), "+v"(p1));
            if (causal && coff64 + 63 > tqbase) mask_gt(p0, p1, tq - coff64, hi);
            if (d & TT_LOWER) mask_le(p0, p1, tq, hi);
            const float rm = pmax(tile_max3(p0, p1));
            const bool move = (rm > -INFINITY) && (!started || rm > THR);
            if (__builtin_expect(__any(move), 0)) {
                asm volatile("" ::: "memory");
                const float dl = move ? rm : 0.f;
                const float f = started ? __builtin_amdgcn_exp2f(-dl) : 1.0f;
                mhat += dl; l *= f; o[0] *= f; o[1] *= f;
#pragma unroll
                for (int r = 0; r < 16; ++r) { p0[r] -= dl; p1[r] -= dl; negm[r] = -mhat; }
                started = started || move;
            }
            asm volatile("" : "+v"(negm));
            ATT_EXP_HALF(p0, 0, 1);
        }
        act_prev = act;
        d = (unsigned)__builtin_amdgcn_readfirstlane((int)tab[t + 1 < n ? t + 1 : n - 1]);
        dI = (unsigned)__builtin_amdgcn_readfirstlane((int)dI_next);
        TP_END(3); TP_BEGIN(4);
        ATT_BAR();
        TP_END(4); TP_END(5);
    }
    if (MK_TPROBE && TPON && wid == 0 && lane == 0) { LAS unsigned long long* ps = (LAS unsigned long long*)(ring + MISC_OFF + 1536); ps[0] += tpacc_; ((LAS unsigned*)(ring + MISC_OFF + 1544))[0] += (unsigned)n; }
    if (act_prev && !(DBG & 1)) ATT_EXP_HALF(p1, 2, 3);
    if (act_prev && !(DBG & 2)) { ATT_PV_HALF(((n - 1) & 3) * 16384, 0); ATT_PV_HALF(((n - 1) & 3) * 16384, 1); }
    __builtin_amdgcn_sched_barrier(0); asm volatile("s_waitcnt vmcnt(0)" ::: "memory");
    ATT_BAR();
    if (!hb) ATT_BAR();
#undef ATT_EXP_HALF
#undef ATT_PV_HALF
#undef ATT_ISSUE
#undef ATT_WAIT_BAR2
}

__device__ __forceinline__ void nsa_item(LAS unsigned char* lds, const bf16* P, const bf16* QR, const float* GN, const bf16* KC, const bf16* VC, bf16* YN,
                                         int b, int g, int tb, int wid, int lane_in, int tid_in) {
    int lane = lane_in, tid = tid_in; asm volatile("" : "+v"(lane), "+v"(tid));
    const int r = wid & 3, ts = wid >> 2, h = 4 * g + r, r32 = lane & 31, hi = lane >> 5;
    const int tq = 32 * ts + r32, t = 64 * tb + tq; const size_t row = (size_t)b * SEQ + t;
    const float g0 = GN[row * 32 + 3 * h], g1 = GN[row * 32 + 3 * h + 1], g2 = GN[row * 32 + 3 * h + 2];
    LAS unsigned* maskw = (LAS unsigned*)(lds + MISC_OFF + 256);
    LAS unsigned* uni = (LAS unsigned*)(lds + MISC_OFF + 768);
    const int vpo = vpo_of(lane);
    const f32x16 zero16 = {0.f, 0.f, 0.f, 0.f, 0.f, 0.f, 0.f, 0.f, 0.f, 0.f, 0.f, 0.f, 0.f, 0.f, 0.f, 0.f};
    f32x16 y[2] = {zero16, zero16};
    if (tid < 128) maskw[tid] = 0u;
    if (tid == 128) { uni[0] = 0u; uni[1] = 0u; }
    __syncthreads();
    const int ntc = ((4 * tb + 2) >> 6) + 1;
    {
        bf16x8 qc[4];
#pragma unroll
        for (int d0 = 0; d0 < 4; ++d0) qc[d0] = *(const bf16x8*)(P + row * LDP + 64 * h + 16 * d0 + 8 * hi);
        const bf16* kcb = KC + (size_t)(b * 2 + g) * 256 * 64; const bf16* vcb = VC + (size_t)(b * 2 + g) * 256 * 64;
#pragma unroll 1
        for (int T = 0; T < ntc; ++T) stage_kv(lds, T * 8192, 32768 + T * 8192, kcb + (size_t)T * 64 * 64, vcb + (size_t)T * 64 * 64, 64, wid, lane);
        __syncthreads();
        const int nlim = t >= 31 ? ((t - 31) >> 4) : -1;
        float m = -1e30f;
#pragma unroll 1
        for (int T = 0; T < ntc; ++T) { f32x16 p0, p1; qkt(p0, p1, lds + T * 8192, qc, zero16, r32, hi); mask_gt(p0, p1, nlim - 64 * T, hi); m = fmaxf(m, tile_max(p0, p1)); }
        m = pmax(m);
        const float mc = -m * C2; float l = 0.f; f32x16 o[2] = {zero16, zero16};
        float carry = 0.f;
        LAS float* Fb = (LAS float*)(lds + 65536) + (wid * 32 + r32) * 65 + hi;
#pragma unroll 1
        for (int T = 0; T < ntc; ++T) {
            f32x16 p0, p1; qkt(p0, p1, lds + T * 8192, qc, zero16, r32, hi); mask_gt(p0, p1, nlim - 64 * T, hi);
            float s = 0.f;
#pragma unroll
            for (int rr = 0; rr < 16; ++rr) { p0[rr] = __builtin_amdgcn_exp2f(fmaf(p0[rr], C2, mc)); p1[rr] = __builtin_amdgcn_exp2f(fmaf(p1[rr], C2, mc)); s += p0[rr] + p1[rr]; }
            l += s;
#pragma unroll
            for (int ph = 0; ph < 2; ++ph)
#pragma unroll
                for (int i = 0; i < 4; ++i) {
                    const float e0 = ph ? p1[4 * i] : p0[4 * i], e1 = ph ? p1[4 * i + 1] : p0[4 * i + 1], e2 = ph ? p1[4 * i + 2] : p0[4 * i + 2], e3 = ph ? p1[4 * i + 3] : p0[4 * i + 3];
                    const float Lr = __shfl_xor(e3, 32);
                    Fb[16 * T + 8 * ph + 2 * i] = ((e0 + e1) + (e2 + e3)) + (hi ? Lr : carry);
                    carry = Lr;
                }
            bf16x8 pa[4]; pack_p(pa, p0, p1);
            pv(o, lds + 32768 + T * 8192, vpo, pa);
        }
        const float lt = psum(l); const float inv = lt > 0.f ? 1.0f / lt : 0.f;
        y[0] = o[0] * (g0 * inv); y[1] = o[1] * (g0 * inv);
        if (hi == 0) ((LAS float*)(lds + 65536 + 66560))[wid * 32 + r32] = inv;
    }
    __syncthreads();
    {
        const int tk = tid >> 3, sub = tid & 7;
        LAS const float* F0 = (LAS const float*)(lds + 65536) + ((tk >> 5) * 128 + (tk & 31)) * 65;
        LAS float* imp = (LAS float*)lds + tk * 68;
        LAS const float* ivp = (LAS const float*)(lds + 65536 + 66560) + (tk >> 5) * 128 + (tk & 31);
        const float iv0 = ivp[0], iv1 = ivp[32], iv2 = ivp[64], iv3 = ivp[96];
        float vj[8];
#pragma unroll
        for (int i = 0; i < 8; ++i) { const int j = 8 * sub + i;
            float v = ((F0[j] * iv0 + F0[32 * 65 + j] * iv1) + F0[64 * 65 + j] * iv2) + F0[96 * 65 + j] * iv3;
            if (j == 0 || j == tb || j == tb - 1) v = INFINITY;
            if (j > tb) v = -INFINITY;
            vj[i] = v; }
        *(LAS f32x4*)(imp + 8 * sub) = (f32x4){vj[0], vj[1], vj[2], vj[3]}; *(LAS f32x4*)(imp + 8 * sub + 4) = (f32x4){vj[4], vj[5], vj[6], vj[7]};
        __syncthreads();
        int rank[8];
#pragma unroll
        for (int i = 0; i < 8; ++i) rank[i] = 0;
#pragma unroll 2
        for (int c4 = 0; c4 < 16; ++c4) {
            const f32x4 vv = *(LAS const f32x4*)(imp + 4 * c4);
#pragma unroll
            for (int e = 0; e < 4; ++e) { const int jj = 4 * c4 + e; const float x = vv[e];
#pragma unroll
                for (int i = 0; i < 8; ++i) rank[i] += (int)(x > vj[i]) | ((int)(x == vj[i]) & (int)(jj < 8 * sub + i)); }
        }
        unsigned bits = 0u;
#pragma unroll
        for (int i = 0; i < 8; ++i) if (rank[i] < 16 && 8 * sub + i <= tb) bits |= 1u << i;
        bits <<= 8 * (sub & 3);
        __hip_atomic_fetch_or(maskw + 2 * tk + (sub >> 2), bits, __ATOMIC_RELAXED, __HIP_MEMORY_SCOPE_WORKGROUP);
        __hip_atomic_fetch_or(uni + (sub >> 2), bits, __ATOMIC_RELAXED, __HIP_MEMORY_SCOPE_WORKGROUP);
        __syncthreads();
    }
    const unsigned long long mymask = ((unsigned long long)maskw[2 * tq + 1] << 32) | maskw[2 * tq];
    const unsigned long long um = ((unsigned long long)(unsigned)__builtin_amdgcn_readfirstlane((int)uni[1]) << 32) | (unsigned)__builtin_amdgcn_readfirstlane((int)uni[0]);
    const size_t brow = (size_t)b * SEQ;
    bf16x8 qr[4];
#pragma unroll
    for (int d0 = 0; d0 < 4; ++d0) qr[d0] = *(const bf16x8*)(QR + row * 512 + 64 * h + 16 * d0 + 8 * hi);
    LAS float* ypark = (LAS float*)(lds + 65536) + tid;
#pragma unroll
    for (int r = 0; r < 16; ++r) { ypark[r * 512] = y[0][r]; ypark[(16 + r) * 512] = y[1][r]; }
    LAS unsigned* tab = (LAS unsigned*)(lds + MISC_OFF + 1024);
    {
        if (tid < 64 && ((um >> tid) & 1ull)) tab[__builtin_popcountll(um & ((1ull << tid) - 1ull))] = (unsigned)tid | ((unsigned)tid << 6) | (tid == tb ? TT_CAUSAL : 0u);
        __syncthreads();
        float l; f32x16 o[2] = {zero16, zero16};
        run_tiles<true>(lds, tab, __builtin_popcountll(um), P + brow * LDP + 768 + 64 * g, P + brow * LDP + 896 + 64 * g, qr, o, l, mymask, 32 * ts, wid, lane, r32, hi, vpo);
        const float lt = psum(l); const float sc = lt > 0.f ? g1 / lt : 0.f;
#pragma unroll
        for (int r = 0; r < 16; ++r) { ypark[r * 512] += o[0][r] * sc; ypark[(16 + r) * 512] += o[1][r] * sc; }
    }
    {
        const int j0 = tb >= 8 ? tb - 8 : 0, nw = tb - j0 + 1;
        if (tid < nw) { const int j = j0 + tid; tab[tid] = (unsigned)j | TT_ALWAYS | (j == tb ? TT_CAUSAL : 0u) | ((tb >= 8 && j == tb - 8) ? TT_LOWER : 0u); }
        __syncthreads();
        float l; f32x16 o[2] = {zero16, zero16};
        run_tiles<false>(lds, tab, nw, P + brow * LDP + 1024 + 64 * g, P + brow * LDP + 1152 + 64 * g, qr, o, l, 0ull, 32 * ts, wid, lane, r32, hi, vpo);
        const float lt = psum(l); const float sc = lt > 0.f ? g2 / lt : 0.f;
#pragma unroll
        for (int r = 0; r < 16; ++r) { y[0][r] = ypark[r * 512] + o[0][r] * sc; y[1][r] = ypark[(16 + r) * 512] + o[1][r] * sc; }
    }
    store_y(YN + row * 512 + 64 * h, y, hi);
}

template <int DBG = 0> __device__ __forceinline__ void moba_item(LAS unsigned char* lds, const bf16* P, const bf16* KMH, const bf16* KML, bf16* YM, int b, int h, int ob, int wid, int lane_in, int tid_in) {
    int lane = lane_in, tid = tid_in; asm volatile("" : "+v"(lane), "+v"(tid));
    const int r32 = lane & 31, hi = lane >> 5, tq = 32 * wid + r32, t = 256 * ob + tq; const size_t row = (size_t)b * SEQ + t;
    bf16x8 qr[4];
#pragma unroll
    for (int d0 = 0; d0 < 4; ++d0) qr[d0] = *(const bf16x8*)(P + row * LDP + 1280 + 64 * h + 16 * d0 + 8 * hi);
    LAS unsigned* uni = (LAS unsigned*)(lds + MISC_OFF + 776);
    const int vpo = vpo_of(lane);
    const f32x16 zero16 = {0.f, 0.f, 0.f, 0.f, 0.f, 0.f, 0.f, 0.f, 0.f, 0.f, 0.f, 0.f, 0.f, 0.f, 0.f, 0.f};
    if (tid == 0) uni[0] = 0u;
    __syncthreads();
    unsigned mymask = 0u;
    if (ob > 0) {
        f32x16 ga = zero16;
        const bf16* kh = KMH + ((size_t)(b * 8 + h) * 16 + (r32 & 15)) * 64 + 8 * hi; const bf16* kl = KML + ((size_t)(b * 8 + h) * 16 + (r32 & 15)) * 64 + 8 * hi;
#pragma unroll
        for (int d0 = 0; d0 < 4; ++d0) { const bf16x8 ah = *(const bf16x8*)(kh + 16 * d0), al = *(const bf16x8*)(kl + 16 * d0);
            ga = __builtin_amdgcn_mfma_f32_32x32x16_bf16(ah, qr[d0], ga, 0, 0, 0); ga = __builtin_amdgcn_mfma_f32_32x32x16_bf16(al, qr[d0], ga, 0, 0, 0); }
        float gv[16];
#pragma unroll
        for (int rr = 0; rr < 8; ++rr) { const float a = ga[rr], bb = __shfl_xor(a, 32); const int n0 = (rr & 3) + 8 * (rr >> 2); gv[n0] = hi ? bb : a; gv[n0 + 4] = hi ? a : bb; }
#pragma unroll
        for (int pick = 0; pick < 3; ++pick) { float best = -INFINITY; int bi = -1;
#pragma unroll
            for (int n = 0; n < 16; ++n) if (n < ob && !((mymask >> n) & 1u) && gv[n] > best) { best = gv[n]; bi = n; }
            if (bi >= 0) mymask |= 1u << bi; }
        unsigned umw = 0u;
#pragma unroll
        for (int n = 0; n < 16; ++n) if (__ballot((mymask >> n) & 1u)) umw |= 1u << n;
        if (lane == 0) __hip_atomic_fetch_or(uni, umw, __ATOMIC_RELAXED, __HIP_MEMORY_SCOPE_WORKGROUP);
    }
    __syncthreads();
    const unsigned um = (unsigned)__builtin_amdgcn_readfirstlane((int)uni[0]);
    const size_t brow = (size_t)b * SEQ;
    LAS unsigned* tab = (LAS unsigned*)(lds + MISC_OFF + 1024);
    if (tid < 4) tab[tid] = (unsigned)(4 * ob + tid) | TT_ALWAYS | TT_CAUSAL | ((unsigned)tid << 14);
    if (tid >= 64 && tid < 80) { const int nb = tid - 64;
        if ((um >> nb) & 1u) { const int base = 4 + 4 * __builtin_popcount(um & ((1u << nb) - 1u));
#pragma unroll
            for (int kt = 0; kt < 4; ++kt) tab[base + kt] = (unsigned)(4 * nb + kt) | ((unsigned)nb << 6); } }
    __syncthreads();
    float l; f32x16 o[2] = {zero16, zero16};
    run_tiles<true, DBG, (DBG == 0)>(lds, tab, 4 + 4 * __builtin_popcount(um), P + brow * LDP + 1792 + 64 * h, P + brow * LDP + 2304 + 64 * h, qr, o, l, (unsigned long long)mymask, 32 * wid, wid, lane, r32, hi, vpo);
    f32x16 y[2] = {zero16, zero16};
    fin_add(y, o, l, 1.0f);
    store_y(YM + row * 512 + 64 * h, y, hi);
}
}

__device__ __forceinline__ float gelu_tanh(float x) { const float y = 0.7978845608028654f * (x + 0.044715f * x * x * x); const float e = __expf(2.f * y); const float th = 1.f - 2.f / (e + 1.f); return 0.5f * x * (1.f + th); }
__device__ __forceinline__ void cmp_bias_item(LAS unsigned char* lds, const float* pe, const float* w1, float* biasout, int tid) {
    LAS float* bp = (LAS float*)lds;
    const int n = tid & 63, pt = tid >> 6; float s = 0.f;
#pragma unroll 8
    for (int k = 256 * pt; k < 256 * pt + 256; ++k) s += pe[k] * w1[(size_t)k * 64 + n];
    bp[pt * 64 + n] = s;
    __syncthreads();
    if (tid < 64) { float t = 0.f;
#pragma unroll
        for (int w = 0; w < 8; ++w) t += bp[w * 64 + tid];
        biasout[tid] = t; }
    __syncthreads();
}
__device__ __forceinline__ void compress_item(LAS unsigned char* lds, const bf16* P, const bf16* W1T, const float* bias, const float* w2, bf16* OUT, int kv, int b, int g, int rt, int wid, int lane, int tid) {
    LAS float* part = (LAS float*)lds;
    LAS float* Hs = (LAS float*)(lds + 65536);
    LAS float* W2s = (LAS float*)(lds + 65536 + 8192);
    const int r32 = lane & 31, hi = lane >> 5;
    __syncthreads();
#pragma unroll
    for (int jj = 0; jj < 2; ++jj) *(LAS f32x4*)(W2s + 4 * (tid + 512 * jj)) = *(const f32x4*)(w2 + 4 * (tid + 512 * jj));
    const bf16* Asrc = P + (size_t)b * SEQ * LDP + 512 + 128 * kv + 64 * g;
    const int rowi = rt * 32 + r32, rowc = rowi < 255 ? rowi : 254;
    f32x16 c0 = {0.f, 0.f, 0.f, 0.f, 0.f, 0.f, 0.f, 0.f, 0.f, 0.f, 0.f, 0.f, 0.f, 0.f, 0.f, 0.f}, c1 = c0;
#pragma unroll 8
    for (int ks = 0; ks < 16; ++ks) {
        const int l = wid * 4 + (ks >> 2), d = (ks & 3) * 16 + 8 * hi, k = wid * 256 + ks * 16 + 8 * hi;
        const bf16x8 a = *(const bf16x8*)(Asrc + (size_t)(16 * rowc + l) * LDP + d);
        const bf16x8 b0 = *(const bf16x8*)(W1T + (size_t)r32 * 2048 + k), b1 = *(const bf16x8*)(W1T + (size_t)(32 + r32) * 2048 + k);
        c0 = __builtin_amdgcn_mfma_f32_32x32x16_bf16(a, b0, c0, 0, 0, 0); c1 = __builtin_amdgcn_mfma_f32_32x32x16_bf16(a, b1, c1, 0, 0, 0);
    }
#pragma unroll
    for (int r = 0; r < 16; ++r) { const int i = att::crow(r, hi); part[(wid * 32 + i) * 64 + r32] = c0[r]; part[(wid * 32 + i) * 64 + 32 + r32] = c1[r]; }
    __syncthreads();
#pragma unroll
    for (int jj = 0; jj < 4; ++jj) { const int e = tid + 512 * jj, n = e & 63; float s = 0.f;
#pragma unroll
        for (int w = 0; w < 8; ++w) s += part[w * 2048 + e];
        Hs[e] = gelu_tanh(s + bias[n]); }
    __syncthreads();
#pragma unroll
    for (int jj = 0; jj < 4; ++jj) { const int e = tid + 512 * jj, i = e >> 6, c = e & 63; float s = 0.f;
#pragma unroll 16
        for (int j = 0; j < 64; ++j) s += Hs[i * 64 + j] * W2s[j * 64 + c];
        const int ro = rt * 32 + i;
        OUT[((size_t)(b * 2 + g) * 256 + ro) * 64 + c] = (ro < 255) ? (bf16)f2bf(s) : (bf16)0; }
}
__device__ __forceinline__ void kmean_item(LAS unsigned char* lds, const bf16* P, bf16* KMH, bf16* KML, int b, int n, int tid) {
    LAS float* ps = (LAS float*)lds;
    const int cg = tid & 63, rg = tid >> 6;
    const bf16* src = P + ((size_t)b * SEQ + 256 * n + 32 * rg) * LDP + 1792 + 8 * cg;
    float a[8] = {0.f, 0.f, 0.f, 0.f, 0.f, 0.f, 0.f, 0.f};
    __syncthreads();
#pragma unroll 8
    for (int i = 0; i < 32; ++i) { const v4u w = *(const v4u*)(src + (size_t)i * LDP);
        a[0] += bflo(w.x); a[1] += bfhi(w.x); a[2] += bflo(w.y); a[3] += bfhi(w.y); a[4] += bflo(w.z); a[5] += bfhi(w.z); a[6] += bflo(w.w); a[7] += bfhi(w.w); }
#pragma unroll
    for (int j = 0; j < 8; ++j) ps[rg * 512 + 8 * cg + j] = a[j];
    __syncthreads();
    float s = 0.f;
#pragma unroll
    for (int w = 0; w < 8; ++w) s += ps[w * 512 + tid];
    s *= (1.0f / 256.0f);
    const unsigned hb = f2bf(s); const float hf = __uint_as_float(hb << 16);
    const int h = tid >> 6, d = tid & 63; const size_t o = ((size_t)(b * 8 + h) * 16 + n) * 64 + d;
    KMH[o] = (bf16)hb; KML[o] = (bf16)f2bf(s - hf);
}

#ifndef MK_DUMMY_MOBA
#define MK_DUMMY_MOBA 0
#endif
#ifndef MK_REP_NSA
#define MK_REP_NSA 0
#endif
#ifndef MK_REP_MOBA
#define MK_REP_MOBA 0
#endif
#ifndef MK_REP
#define MK_REP 0
#endif
#ifndef MK_PH
#define MK_PH 0x3ff
#endif
struct Args { const float* in[16]; float* out; unsigned char* ws; };
#ifndef MK_SKIP_NSA
#define MK_SKIP_NSA 0
#endif
#ifndef MK_SKIP_MOBA
#define MK_SKIP_MOBA 0
#endif
__global__ void __launch_bounds__(NWAVES * 64, 2) mega_fwd(Args a) {
    extern __shared__ __attribute__((aligned(16))) unsigned char lds_raw[];
    LAS unsigned char* lds = (LAS unsigned char*)lds_raw;
    const int tid = threadIdx.x, lane = tid & 63, wave = __builtin_amdgcn_readfirstlane(tid >> 6);
    const int G = gridDim.x, bx = blockIdx.x; const int vcu = (G % 8 == 0) ? (bx % 8) * (G / 8) + bx / 8 : bx;
    unsigned char* ws = a.ws;
    const float* x = a.in[0]; const float* norm1_g = a.in[1]; const float* w_in = a.in[2]; const float* pe_k = a.in[3]; const float* pe_v = a.in[4];
    const float* ck_w1 = a.in[5]; const float* ck_w2 = a.in[6]; const float* cv_w1 = a.in[7]; const float* cv_w2 = a.in[8];
    const float* w_upn = a.in[9]; const float* w_upm = a.in[10]; const float* w_out = a.in[11]; const float* norm2_g = a.in[12];
    const float* w_ff1 = a.in[13]; const float* w_ff2 = a.in[14]; const float* normf_g = a.in[15];
    float* out = a.out;
    bf16* WIN = (bf16*)(ws + WS_WIN); bf16* WUPN = (bf16*)(ws + WS_WUPN); bf16* WUPM = (bf16*)(ws + WS_WUPM); bf16* WOUT = (bf16*)(ws + WS_WOUT);
    bf16* WFF1 = (bf16*)(ws + WS_WFF1); bf16* WFF2 = (bf16*)(ws + WS_WFF2); bf16* WC1K = (bf16*)(ws + WS_WC1K); bf16* WC1V = (bf16*)(ws + WS_WC1V);
    float* ROPE = (float*)(ws + WS_ROPE); bf16* KC = (bf16*)(ws + WS_KC); bf16* VC = (bf16*)(ws + WS_VC); bf16* KMH = (bf16*)(ws + WS_KMH); bf16* KML = (bf16*)(ws + WS_KML);
    float* CBIAS = (float*)(ws + WS_KML + 192 * 1024); float* SSQ = (float*)(ws + WS_SSQ);
    float* GN = (float*)(ws + WS_GN); bf16* QR = (bf16*)(ws + WS_QR); bf16* HN = (bf16*)(ws + WS_HN); bf16* YN = (bf16*)(ws + WS_YN); bf16* YM = (bf16*)(ws + WS_YM);
    bf16* MIX = (bf16*)(ws + WS_MIX); bf16* P = (bf16*)(ws + WS_P); bf16* U = (bf16*)(ws + WS_U);
    gu32* ctl = (gu32*)(ws + WS_CTL);

    for (int u = tid; u < (LDS_BYTES - MISC_OFF) / 4; u += NWAVES * 64) ((LAS unsigned*)(lds + MISC_OFF))[u] = 0u;
    __syncthreads();
    XcdBarrier bar = xcd_barrier_post((unsigned*)(ctl + CW_BAR), (volatile LAS unsigned*)(lds + MISC_OFF) + 8);

#if (MK_PH >> 0) & 1
    for (int rep_ = 0; rep_ < 1 + ((MK_REP >> 0) & 1); ++rep_) {
    {
        LAS float* scr = (LAS float*)(lds + wave * 16384);
        const int gw = vcu * NWAVES + wave, NGW = G * NWAVES;
        constexpr int I_WIN = 16 * 160, I_UP = 8 * 32, I_OUT = 16 * 32, I_FF1 = 16 * 128, I_FF2 = 64 * 32, I_C1 = 32 * 2;
        constexpr int NITEMS = I_WIN + 2 * I_UP + I_OUT + I_FF1 + I_FF2 + 2 * I_C1;
        for (int it = gw; it < NITEMS; it += NGW) {
            int r = it;
            if (r < I_WIN) { transpose_item(w_in, 1024, INW, NPROJ, WIN, scr, r, lane, true); continue; } r -= I_WIN;
            if (r < I_UP) { transpose_item(w_upn, 512, 1024, 1024, WUPN, scr, r, lane, false); continue; } r -= I_UP;
            if (r < I_UP) { transpose_item(w_upm, 512, 1024, 1024, WUPM, scr, r, lane, false); continue; } r -= I_UP;
            if (r < I_OUT) { transpose_item(w_out, 1024, 1024, 1024, WOUT, scr, r, lane, false); continue; } r -= I_OUT;
            if (r < I_FF1) { transpose_item(w_ff1, 1024, 4096, 4096, WFF1, scr, r, lane, false); continue; } r -= I_FF1;
            if (r < I_FF2) { transpose_item(w_ff2, 4096, 1024, 1024, WFF2, scr, r, lane, false); continue; } r -= I_FF2;
            if (r < I_C1) { transpose_item(ck_w1, 2048, 64, 64, WC1K, scr, r, lane, false); continue; } r -= I_C1;
            transpose_item(cv_w1, 2048, 64, 64, WC1V, scr, r, lane, false);
        }
        for (int idx = gw * 64 + lane; idx < SEQ * 8; idx += NGW * 64) {
            const int pos = idx >> 3, i = idx & 7;
            const float inv = powf(500000.0f, -(float)i * 0.125f), ang = (float)pos * inv;
            ROPE[pos * 16 + i] = cosf(ang); ROPE[pos * 16 + 8 + i] = sinf(ang);
        }
        for (int m = gw; m < NTOK; m += 2 * NGW) rms_row2(x + (size_t)m * DMODEL, x + (size_t)(m + NGW) * DMODEL, norm1_g, HN + (size_t)m * DMODEL, HN + (size_t)(m + NGW) * DMODEL, lane);
        if (bx < 2) { __syncthreads(); cmp_bias_item(lds, bx ? pe_v : pe_k, bx ? cv_w1 : ck_w1, CBIAS + 64 * bx, tid); }
    }
    xcd_barrier(bar);

    }
#endif
#if (MK_PH >> 1) & 1
    for (int rep_ = 0; rep_ < 1 + ((MK_REP >> 1) & 1); ++rep_) {
    {
        pg8::Gemm g{HN, WIN, HN, WIN, NTOK, NPROJ, DMODEL}; pg8::StaticOrder S; S.init(NTOK, NPROJ, G, bx);
        EpiProj E{P, QR, GN, ROPE};
        pg8::gemm_phase<EpiProj, pg8::StaticOrder, true, true>(lds, g, S, E);
    }
    xcd_barrier(bar);

    }
#endif
#if (MK_PH >> 2) & 1
    for (int rep_ = 0; rep_ < 1 + ((MK_REP >> 2) & 1); ++rep_) {
    for (int it = vcu; it < 256; it += G) {
        const int kv = it >> 7, b = (it >> 4) & 7, g = (it >> 3) & 1, rt = it & 7;
        compress_item(lds, P, kv ? WC1V : WC1K, CBIAS + 64 * kv, kv ? cv_w2 : ck_w2, kv ? VC : KC, kv, b, g, rt, wave, lane, tid);
    }
    for (int it = (vcu + 128) % G; it < 128; it += G) kmean_item(lds, P, KMH, KML, it >> 4, it & 15, tid);
    xcd_barrier(bar);

    }
#endif
#if (MK_PH >> 3) & 1
    for (int rep_ = 0; rep_ < 1 + ((MK_REP >> 3) & 1); ++rep_) {
    {
#if MK_SKIP_NSA
        for (size_t i = (size_t)bx * 512 + tid; i < (size_t)NTOK * 512 / 8; i += (size_t)G * 512) ((v4u*)YN)[i] = (v4u){0u, 0u, 0u, 0u};
#else
        for (int rn_ = 0; rn_ < 1 + MK_REP_NSA; ++rn_)
        for (int it = vcu; it < 256; it += G) {
            const int bg = it >> 4, s = it & 15;
#pragma unroll 1
            for (int k = 0; k < 4; ++k) { const int tb = (k == 0) ? 63 - s : (k == 1) ? 32 + s : (k == 2) ? 31 - s : s;
                att::nsa_item(lds, P, QR, GN, KC, VC, YN, bg >> 1, bg & 1, tb, wave, lane, tid); }
        }
    }
#endif
#if MK_SKIP_MOBA
        for (size_t i = (size_t)bx * 512 + tid; i < (size_t)NTOK * 512 / 8; i += (size_t)G * 512) ((v4u*)YM)[i] = (v4u){0u, 0u, 0u, 0u};
#else
#if MK_DUMMY_MOBA
        for (int it = vcu; it < 256; it += G) {
            const int bh = it >> 2, s = it & 3;
#pragma unroll 1
            for (int k = 0; k < 4; ++k) { const int ob = (k == 0) ? 15 - s : (k == 1) ? 8 + s : (k == 2) ? 7 - s : s;
                att::moba_item<MK_DUMMY_MOBA>(lds, P, KMH, KML, MIX, bh >> 3, bh & 7, ob, wave, lane, tid); }
        }
#endif
        for (int rm_ = 0; rm_ < 1 + MK_REP_MOBA; ++rm_)
        for (int it = vcu; it < 256; it += G) {
            const int grp = it >> 4, j = it & 15;
#pragma unroll 1
            for (int k = 0; k < 4; ++k) { const int bh = grp * 4 + k; const int ob = (k & 1) ? 15 - j : j;
                att::moba_item(lds, P, KMH, KML, YM, bh >> 3, bh & 7, ob, wave, lane, tid); }
        }
#endif
#if MK_TPROBE
        __syncthreads();
        if (bx == 0 && tid == 0) { const unsigned long long sum = *(LAS unsigned long long*)(lds + MISC_OFF + 1536); const unsigned cnt = *(LAS unsigned*)(lds + MISC_OFF + 1544);
            ((float*)(ws + WS_CTL))[8192] = cnt ? (float)sum / (float)cnt : 0.f; }
#endif
    }
    xcd_barrier(bar);

#endif
#if (MK_PH >> 4) & 1
    for (int rep_ = 0; rep_ < 1 + ((MK_REP >> 4) & 1); ++rep_) {
    {
        pg8::Gemm g{YN, WUPN, YM, WUPM, NTOK, DMODEL, 512}; pg8::PairOrder S; S.init(NTOK, DMODEL, G, bx);
        EpiMerge E{P, MIX};
        pg8::gemm_phase<EpiMerge, pg8::PairOrder, true, true>(lds, g, S, E);
    }
    xcd_barrier(bar);

    }
#endif
#if (MK_PH >> 5) & 1
    for (int rep_ = 0; rep_ < 1 + ((MK_REP >> 5) & 1); ++rep_) {
    {
        pg8::Gemm g{MIX, WOUT, MIX, WOUT, NTOK, DMODEL, DMODEL}; pg8::StaticOrder S; S.init(NTOK, DMODEL, G, bx);
        EpiResNorm E{x, out, HN, norm2_g, SSQ};
        pg8::gemm_phase<EpiResNorm, pg8::StaticOrder, true, true>(lds, g, S, E);
    }
    xcd_barrier(bar);

    }
#endif
#if (MK_PH >> 7) & 1
    for (int rep_ = 0; rep_ < 1 + ((MK_REP >> 7) & 1); ++rep_) {
    {
        pg8::Gemm g{HN, WFF1, HN, WFF1, NTOK, DFF, DMODEL}; pg8::StaticOrder S; S.init(NTOK, DFF, G, bx);
        EpiRelu2 E{U, SSQ};
        pg8::gemm_phase<EpiRelu2, pg8::StaticOrder, true, true>(lds, g, S, E);
    }
    xcd_barrier(bar);

    }
#endif
#if (MK_PH >> 8) & 1
    for (int rep_ = 0; rep_ < 1 + ((MK_REP >> 8) & 1); ++rep_) {
    {
        pg8::Gemm g{U, WFF2, U, WFF2, NTOK, DMODEL, DFF}; pg8::StaticOrder S; S.init(NTOK, DMODEL, G, bx);
        EpiRes E{out, out};
        pg8::gemm_phase<EpiRes, pg8::StaticOrder, true, true>(lds, g, S, E);
    }
    xcd_barrier(bar);

    }
#endif
#if (MK_PH >> 9) & 1
    for (int rep_ = 0; rep_ < 1 + ((MK_REP >> 9) & 1); ++rep_) {
    {
        const int gw = vcu * NWAVES + wave, NGW = G * NWAVES;
#if MK_TPROBE
        const float tpv = ((const float*)(ws + WS_CTL))[8192];
        const float tpd = sqrtf(tpv * (MK_TPROBE == 6 ? 4e-7f : 2e-8f));
        for (int m = gw; m < NTOK; m += NGW) { rms_row<true>(out + (size_t)m * DMODEL, normf_g, out + (size_t)m * DMODEL, lane);
            f32x4* orow = (f32x4*)(out + (size_t)m * DMODEL) + lane;
#pragma unroll
            for (int j = 0; j < 4; ++j) orow[64 * j] = orow[64 * j] + tpd; }
#else
        for (int m = gw; m < NTOK; m += NGW) rms_row<true>(out + (size_t)m * DMODEL, normf_g, out + (size_t)m * DMODEL, lane);
#endif
    }
    }
#endif
}

extern "C" void kernel_launch(void* const* d_in, const int* in_sizes, int n_in, void* d_out, int out_size, void* d_ws, size_t ws_size, hipStream_t stream) {
    static int grid = 0;
    if (grid == 0) {
        if (n_in != 16 || in_sizes[0] != NTOK * DMODEL || out_size != NTOK * DMODEL || ws_size < WS_END) {
            fprintf(stderr, "kernel_launch: unexpected shapes (n_in %d, in0 %d, out %d, ws %zu); nothing launched\n", n_in, n_in > 0 ? in_sizes[0] : -1, out_size, ws_size); grid = -1; return; }
        int dev = 0, cus = 0, per_cu = 0;
        if (hipGetDevice(&dev) != hipSuccess || hipDeviceGetAttribute(&cus, hipDeviceAttributeMultiprocessorCount, dev) != hipSuccess) { fprintf(stderr, "kernel_launch: device query failed\n"); grid = -1; return; }
        if (hipFuncSetAttribute((const void*)mega_fwd, hipFuncAttributeMaxDynamicSharedMemorySize, LDS_BYTES) != hipSuccess) { fprintf(stderr, "kernel_launch: hipFuncSetAttribute failed\n"); grid = -1; return; }
        if (hipOccupancyMaxActiveBlocksPerMultiprocessor(&per_cu, (const void*)mega_fwd, NWAVES * 64, LDS_BYTES) != hipSuccess || per_cu < 1)
            fprintf(stderr, "kernel_launch: note: occupancy query reports %d workgroups per CU\n", per_cu);
        (void)hipGetLastError();
        grid = cus;
    }
    if (grid < 0) return;
    if (hipMemsetAsync((char*)d_ws + WS_CTL, 0, CTL_ZERO_BYTES, stream) != hipSuccess) { fprintf(stderr, "kernel_launch: hipMemsetAsync failed\n"); return; }
    Args a{};
    for (int i = 0; i < 16; ++i) a.in[i] = (const float*)d_in[i];
    a.out = (float*)d_out; a.ws = (unsigned char*)d_ws;
    hipLaunchKernelGGL(mega_fwd, dim3(grid), dim3(NWAVES * 64), LDS_BYTES, stream, a);
    const hipError_t le = hipPeekAtLastError();
    if (le != hipSuccess) fprintf(stderr, "kernel_launch: launch failed: %s\n", hipGetErrorName(le));
}
```
